# Optimizing an MI355X kernel written in HIP

```python
import jax, jax.numpy as jnp
from jax import lax
import numpy as np

D_MODEL = 1024
BATCH = 16
SEQ = 2048
DEPTH = 2

CHUNK = 64
EPS = 1e-6
POOL_WINDOWS = (2, 4, 8, 16)
POOL_GROUP = D_MODEL // 4
POOL_WIDTH = 4 * POOL_GROUP
SGU_LEN = 128
SGU_HEAD_DIM = 128
SGU_WIDTH = D_MODEL
SGU_HEADS = SGU_WIDTH // SGU_HEAD_DIM
GLA_HEADS = 4
GLA_KW = D_MODEL // 2
GLA_VW = D_MODEL
GLA_DK = GLA_KW // GLA_HEADS
GLA_DV = GLA_VW // GLA_HEADS
GLA_RANK = 16
GLA_TAU = 16.0
SB_HEAD_DIM = 128
SB_WIDTH = D_MODEL
SB_HEADS = SB_WIDTH // SB_HEAD_DIM
SB_QBLOCK = 128
EVEN_SIZES = (POOL_WIDTH, SGU_WIDTH, SGU_WIDTH, POOL_WIDTH + SGU_WIDTH)
ODD_SIZES = (GLA_KW, GLA_KW, GLA_VW, GLA_RANK, SB_WIDTH, SB_WIDTH, SB_WIDTH, GLA_VW + SB_WIDTH)
EVEN_IN = sum(EVEN_SIZES)
ODD_IN = sum(ODD_SIZES)
EVEN_MIX = POOL_WIDTH + SGU_WIDTH
ODD_MIX = GLA_VW + SB_WIDTH
N_EVEN = (DEPTH + 1) // 2
N_ODD = DEPTH // 2

kernel_name = "hybrid_pool_sgu_gla_stickbreak_adaln"


def _split(t, sizes):
    idx = [int(i) for i in np.cumsum(sizes)[:-1]]
    return jnp.split(t, idx, axis=-1)


def rmsnorm(x, g):
    xf = x.astype(jnp.float32)
    y = xf * lax.rsqrt(jnp.mean(xf * xf, axis=-1, keepdims=True) + EPS)
    return (y * g.astype(jnp.float32)).astype(x.dtype)


def ada_modulate(x, c, norm_g, ada_w, ada_b):
    ada = jax.nn.silu(c) @ ada_w + ada_b
    shift, scale, gate = jnp.split(ada, 3, axis=-1)
    h = rmsnorm(x, norm_g) * (1.0 + scale[:, None, :]) + shift[:, None, :]
    return h, gate[:, None, :]


def pool_mixer(a, pool_w, pool_scale):
    B_, S, _ = a.shape
    af = a.astype(jnp.float32)
    cs = jnp.concatenate([jnp.zeros_like(af[:, :1]), jnp.cumsum(af, axis=1)], axis=1)
    t = np.arange(S)
    outs = []
    for g, w in enumerate(POOL_WINDOWS):
        sl = slice(g * POOL_GROUP, (g + 1) * POOL_GROUP)
        start = np.maximum(t + 1 - w, 0)
        count = jnp.asarray((t + 1 - start).astype(np.float32))
        win_sum = cs[:, 1:, sl] - cs[:, start, sl]
        outs.append(win_sum / count[None, :, None] - af[..., sl])
    p = jnp.stack(outs, axis=2).astype(a.dtype)
    y = jnp.einsum('bsgc,gcd->bsgd', p, pool_w).reshape(B_, S, POOL_WIDTH)
    return y * pool_scale


def spatial_gating(u, v, norm_g, w_s, b_s):
    B_, S, _ = u.shape
    n = S // SGU_LEN
    vh = rmsnorm(v, norm_g).reshape(B_, n, SGU_LEN, SGU_HEADS, SGU_HEAD_DIM)
    mask = jnp.tril(jnp.ones((SGU_LEN, SGU_LEN), dtype=bool))
    w = jnp.where(mask[None], w_s, jnp.zeros_like(w_s))
    z = jnp.einsum('hts,bnshd->bnthd', w, vh) + b_s.T[None, None, :, :, None]
    return u * z.reshape(B_, S, SGU_WIDTH)


def gla(q, k, v, log_a):
    B_, S = q.shape[:2]
    n = S // CHUNK
    r = lambda t: t.astype(jnp.float32).reshape(B_, n, CHUNK, *t.shape[2:])
    qf = r(q) * (GLA_DK ** -0.5)
    kf, vf, la = r(k), r(v), r(log_a)
    bcum = jnp.cumsum(la, axis=2)
    b_last = bcum[:, :, -1]
    q_dec = qf * jnp.exp(bcum)
    k_inv = kf * jnp.exp(-bcum)
    k_end = kf * jnp.exp(b_last[:, :, None] - bcum)
    mask = jnp.tril(jnp.ones((CHUNK, CHUNK), dtype=bool))
    att = jnp.einsum('bnthk,bnshk->bnhts', q_dec, k_inv)
    att = jnp.where(mask, att, 0.0)
    o_intra = jnp.einsum('bnhts,bnshv->bnthv', att, vf)

    def step(state, xs):
        qd, ke, vc, bl = xs
        o = jnp.einsum('bthk,bhkv->bthv', qd, state)
        state = jnp.exp(bl)[..., None] * state + jnp.einsum('bshk,bshv->bhkv', ke, vc)
        return state, o

    s0 = jnp.zeros((B_, GLA_HEADS, GLA_DK, GLA_DV), jnp.float32)
    xs = (jnp.moveaxis(q_dec, 1, 0), jnp.moveaxis(k_end, 1, 0), jnp.moveaxis(vf, 1, 0), jnp.moveaxis(b_last, 1, 0))
    _, o_inter = lax.scan(step, s0, xs)
    o = o_intra + jnp.moveaxis(o_inter, 0, 1)
    return o.reshape(B_, S, GLA_HEADS, GLA_DV).astype(v.dtype)


def stick_breaking(q, k, v):
    B_, S, H, Dh = q.shape
    scale = Dh ** -0.5
    outs = []
    for i in range(S // SB_QBLOCK):
        q0, q1 = i * SB_QBLOCK, (i + 1) * SB_QBLOCK
        z = jnp.einsum('bthd,bshd->bhts', q[:, q0:q1], k[:, :q1]).astype(jnp.float32) * scale
        strict = np.arange(q1)[None, :] < np.arange(q0, q1)[:, None]
        log_beta = jax.nn.log_sigmoid(z)
        log_1m = jnp.where(strict, jax.nn.log_sigmoid(-z), 0.0)
        after = lax.cumsum(log_1m, axis=3, reverse=True) - log_1m
        w = jnp.where(strict, jnp.exp(log_beta + after), 0.0)
        outs.append(jnp.einsum('bhts,bshd->bthd', w.astype(v.dtype), v[:, :q1]))
    return jnp.concatenate(outs, axis=1)


def even_layer(x, c, norm_g, ada_w, ada_b, in_w, pool_w, pool_scale, sgu_norm_g, sgu_w, sgu_b, out_w):
    h, gate_res = ada_modulate(x, c, norm_g, ada_w, ada_b)
    a, u, v, gate = _split(h @ in_w, EVEN_SIZES)
    ya = pool_mixer(a, pool_w, pool_scale)
    yb = spatial_gating(u, v, sgu_norm_g, sgu_w, sgu_b)
    y = jnp.concatenate([ya, yb], axis=-1) * jax.nn.silu(gate)
    return x + gate_res * (y @ out_w)


def odd_layer(x, c, norm_g, ada_w, ada_b, in_w, gate_w, gate_b, gla_norm_g, out_w):
    B_, S, _ = x.shape
    h, gate_res = ada_modulate(x, c, norm_g, ada_w, ada_b)
    gq, gk, gv, glr, sq, sk, sv, gate = _split(h @ in_w, ODD_SIZES)
    log_a = jax.nn.log_sigmoid((glr @ gate_w + gate_b).astype(jnp.float32)) / GLA_TAU
    hd = lambda t, n, d: t.reshape(B_, S, n, d)
    yc = gla(hd(gq, GLA_HEADS, GLA_DK), hd(gk, GLA_HEADS, GLA_DK), hd(gv, GLA_HEADS, GLA_DV),
             hd(log_a, GLA_HEADS, GLA_DK))
    yc = rmsnorm(yc, gla_norm_g).reshape(B_, S, GLA_VW)
    yd = stick_breaking(hd(sq, SB_HEADS, SB_HEAD_DIM), hd(sk, SB_HEADS, SB_HEAD_DIM),
                        hd(sv, SB_HEADS, SB_HEAD_DIM)).reshape(B_, S, SB_WIDTH)
    y = jnp.concatenate([yc, yd], axis=-1) * jax.nn.silu(gate)
    return x + gate_res * (y @ out_w)


def setup_inputs(seed: int = 0) -> dict:
    key = jax.random.key(seed)
    ks = jax.random.split(key, 20)
    nrm = lambda k, shape, s: jax.random.normal(k, shape, jnp.float32) * s
    return {
        "x": nrm(ks[0], (BATCH, SEQ, D_MODEL), 1.0),
        "c": nrm(ks[1], (BATCH, D_MODEL), 1.0),
        "ada_w": nrm(ks[2], (DEPTH, D_MODEL, 3 * D_MODEL), 0.5 * D_MODEL ** -0.5),
        "ada_b": nrm(ks[3], (DEPTH, 3 * D_MODEL), 0.02),
        "norm_g": 1.0 + nrm(ks[4], (DEPTH, D_MODEL), 0.05),
        "even_in_w": nrm(ks[5], (N_EVEN, D_MODEL, EVEN_IN), D_MODEL ** -0.5),
        "pool_w": nrm(ks[6], (N_EVEN, 4, POOL_GROUP, POOL_GROUP), POOL_GROUP ** -0.5),
        "pool_scale": 1.0 + nrm(ks[7], (N_EVEN, POOL_WIDTH), 0.1),
        "sgu_norm_g": 1.0 + nrm(ks[8], (N_EVEN, SGU_WIDTH), 0.05),
        "sgu_w": nrm(ks[9], (N_EVEN, SGU_HEADS, SGU_LEN, SGU_LEN), SGU_LEN ** -0.5),
        "sgu_b": 1.0 + nrm(ks[10], (N_EVEN, SGU_HEADS, SGU_LEN), 0.1),
        "even_out_w": nrm(ks[11], (N_EVEN, EVEN_MIX, D_MODEL), EVEN_MIX ** -0.5),
        "odd_in_w": nrm(ks[12], (N_ODD, D_MODEL, ODD_IN), D_MODEL ** -0.5),
        "gla_gate_w": nrm(ks[13], (N_ODD, GLA_RANK, GLA_KW), GLA_RANK ** -0.5),
        "gla_gate_b": nrm(ks[14], (N_ODD, GLA_KW), 0.1),
        "gla_norm_g": 1.0 + nrm(ks[15], (N_ODD, GLA_HEADS, GLA_DV), 0.05),
        "odd_out_w": nrm(ks[16], (N_ODD, ODD_MIX, D_MODEL), ODD_MIX ** -0.5),
        "final_g": 1.0 + nrm(ks[17], (D_MODEL,), 0.05),
    }


def reference(x, c, ada_w, ada_b, norm_g, even_in_w, pool_w, pool_scale, sgu_norm_g, sgu_w, sgu_b,
              even_out_w, odd_in_w, gla_gate_w, gla_gate_b, gla_norm_g, odd_out_w, final_g):
    for i in range(DEPTH):
        j = i // 2
        if i % 2 == 0:
            x = even_layer(x, c, norm_g[i], ada_w[i], ada_b[i], even_in_w[j], pool_w[j], pool_scale[j],
                           sgu_norm_g[j], sgu_w[j], sgu_b[j], even_out_w[j])
        else:
            x = odd_layer(x, c, norm_g[i], ada_w[i], ada_b[i], odd_in_w[j], gla_gate_w[j], gla_gate_b[j],
                          gla_norm_g[j], odd_out_w[j])
    return rmsnorm(x, final_g)
```

```cpp
#include <hip/hip_runtime.h>
#include <hip/hip_cooperative_groups.h>
#include <cstdio>
namespace cg = cooperative_groups;

#ifndef N_LAUNCH_MODE
#define N_LAUNCH_MODE 1
#endif

#define LAS __attribute__((address_space(3)))
typedef unsigned short bf16_t;
typedef short bf16x8 __attribute__((ext_vector_type(8)));
typedef float f32x4 __attribute__((ext_vector_type(4)));
typedef unsigned u32x4 __attribute__((ext_vector_type(4)));
typedef unsigned u32x2 __attribute__((ext_vector_type(2)));

constexpr int NB = 16, SEQ = 2048, D = 1024, M = NB * SEQ;
constexpr float EPS = 1e-6f;
constexpr int LDS_BYTES = 131072 + 16;
constexpr int NPHASE = 13;

constexpr size_t WS_BAR = 0;
constexpr size_t WS_IN0T = 16384;
constexpr size_t WS_OUT0T = WS_IN0T + 5120ull * 1024 * 2;
constexpr size_t WS_IN1T = WS_OUT0T + 1024ull * 2048 * 2;
constexpr size_t WS_OUT1T = WS_IN1T + 7168ull * 1024 * 2;
constexpr size_t WS_POOLT = WS_OUT1T + 1024ull * 2048 * 2;
constexpr size_t WS_SGUW = WS_POOLT + 1024ull * 256 * 2;
constexpr size_t WS_ADA = WS_SGUW + 8ull * 128 * 128 * 4;
constexpr size_t WS_GLR = WS_ADA + 2ull * 16 * 3072 * 4;
constexpr size_t WS_SSQ = WS_GLR + (size_t)M * 16 * 4;
constexpr size_t WS_H = WS_SSQ + (size_t)M * 32 * 4;
constexpr size_t WS_BUFA = WS_H + (size_t)M * 1024 * 2;
constexpr size_t WS_BUFV = WS_BUFA + (size_t)M * 4096 * 2;
constexpr size_t WS_EB = WS_BUFV + (size_t)M * 2048 * 2;
constexpr size_t WS_END = WS_EB + 2048ull * 128 * 4;

typedef float f32x2 __attribute__((ext_vector_type(2)));
typedef __bf16 bf16x2_t __attribute__((ext_vector_type(2)));
__device__ __forceinline__ unsigned cvt_pk_bf16(float lo, float hi) { const f32x2 v = {lo, hi}; return __builtin_bit_cast(unsigned, __builtin_convertvector(v, bf16x2_t)); }
__device__ __forceinline__ unsigned cvt_pk_bf16_asm(float lo, float hi) { unsigned r; asm("v_cvt_pk_bf16_f32 %0, %1, %2" : "=v"(r) : "v"(lo), "v"(hi)); return r; }
__device__ __forceinline__ float bf2f(bf16_t b) { return __uint_as_float(((unsigned)b) << 16); }
__device__ __forceinline__ float bflo(unsigned u) { return __uint_as_float(u << 16); }
__device__ __forceinline__ float bfhi(unsigned u) { return __uint_as_float(u & 0xffff0000u); }
__device__ __forceinline__ bf16_t f2bf(float f) { return (bf16_t)(cvt_pk_bf16(f, 0.f) & 0xffffu); }
__device__ __forceinline__ float silu_f(float x) { return x * __builtin_amdgcn_rcpf(1.0f + __builtin_amdgcn_exp2f(-1.4426950408889634f * x)); }
__device__ __forceinline__ float logsig2_f(float z2) { return fminf(z2, 0.f) - __builtin_amdgcn_logf(1.0f + __builtin_amdgcn_exp2f(-fabsf(z2))); }
__device__ __forceinline__ int vslot(int x) { return ((x >> 2) & 3) * 8 + ((x >> 4) & 1) * 4 + (x & 3); }
__device__ __forceinline__ float wave_sum(float v) {
#pragma unroll
    for (int m = 32; m >= 1; m >>= 1) v += __shfl_xor(v, m);
    return v;
}
__device__ __forceinline__ bf16x8 pack8(f32x4 a, f32x4 b) {
    u32x4 w; w.x = cvt_pk_bf16(a[0], a[1]); w.y = cvt_pk_bf16(a[2], a[3]); w.z = cvt_pk_bf16(b[0], b[1]); w.w = cvt_pk_bf16(b[2], b[3]);
    return __builtin_bit_cast(bf16x8, w);
}
__device__ __forceinline__ int opaque_tid(int wv) { int t = (wv << 6) | (int)__builtin_amdgcn_mbcnt_hi(~0u, __builtin_amdgcn_mbcnt_lo(~0u, 0u)); asm volatile("" : "+v"(t)); return t; }
#define MFMA16(a, b, c) __builtin_amdgcn_mfma_f32_16x16x32_bf16((a), (b), (c), 0, 0, 0)

namespace pg8 {
constexpr int BM = 256, BK = 64, HALF = 128, HTB = HALF * BK * 2, STAGE_BYTES = 8 * HTB, NXCD = 8, WGM = 8;
__host__ __device__ __forceinline__ int lds_byte(int r, int c) { const int st = (r >> 4) * 2 + (c >> 5), rr = r & 15, cc = c & 31, ob = rr * 64 + cc * 2; return st * 1024 + (ob ^ (((ob >> 9) & 1) << 5)); }
__host__ __device__ __forceinline__ void stage_rc(int b, int& R, int& C) { const int st = b / 1024, sb = b % 1024, swz = sb ^ (((sb >> 9) & 1) << 5); R = (st >> 1) * 16 + swz / 64; C = (st & 1) * 32 + (swz % 64) / 2; }
__host__ __device__ __forceinline__ int perm32(int rho) { const int n = rho >> 4, i = rho & 15; return 8 * (i >> 2) + 4 * n + (i & 3); }

struct Unit { int pm, pn; unsigned aoff; };
struct Gemm { const bf16_t* A; const bf16_t* A1; const bf16_t* Bt; };

struct StaticOrder {
    int nM, nN, nwg, G, c;
    __device__ void init(int M_, int N_, int G_, int c_) { nM = M_ / BM; nN = N_ / BM; nwg = nM * nN; G = G_; c = c_; }
    __device__ bool next(int i, Unit& u) const {
        const long L = (long)i * G + c; if (L >= nwg) return false;
        int wgid = (int)L; { const int q = nwg / NXCD, r = nwg % NXCD, xcd = wgid % NXCD, off = wgid / NXCD; wgid = (xcd < r ? xcd * (q + 1) : r * (q + 1) + (xcd - r) * q) + off; }
        const int nig = WGM * nN, gid = wgid / nig, fm = gid * WGM, gsz = (nM - fm) < WGM ? (nM - fm) : WGM;
        u.pm = fm + ((wgid % nig) % gsz); u.pn = (wgid % nig) / gsz; u.aoff = 0; return true;
    }
};
struct PoolOrder {
    int G, c;
    __device__ bool next(int i, Unit& u) const {
        const int L = i * G + c; if (L >= 512) return false;
        u.pm = L >> 2; u.pn = L & 3; u.aoff = (unsigned)(u.pn * 256 * 2); return true;
    }
};

template <class Epi, class Sched, bool SWAP, int K, int lda, int ksplit>
__device__ __forceinline__ void gemm_phase(int wv, LAS unsigned char* lds, const Gemm g, const Sched& S, const Epi& E) {
    const int tid = opaque_tid(wv), wid = __builtin_amdgcn_readfirstlane(tid >> 6), lane = tid & 63, wr = wid >> 2, wc = wid & 3, fr = lane & 15, fq = lane >> 4;
    constexpr int nt = K / BK;
    unsigned voffA[2], voffB[2];
#pragma unroll
    for (int i = 0; i < 2; ++i) { int R, C; stage_rc(tid * 16 + i * 8192, R, C); const int Rb = Epi::PERM ? ((R & ~31) + perm32(R & 31)) : R;
        voffA[i] = (unsigned)(R * lda + C) * 2u; voffB[i] = (unsigned)(Rb * K + C) * 2u; }
    const size_t kstep = (size_t)(BK * 2);
    const size_t hstepA = (size_t)HALF * lda * 2, hstepB = (size_t)HALF * K * 2;
    const size_t tstepA = 2 * hstepA, tstepB = 2 * hstepB;
    const unsigned ldsw = (unsigned)wid * 1024u;
    const int aoff = lds_byte(wr * 64 + fr, fq * 8), boff = lds_byte(wc * 32 + fr, fq * 8);
#define PG8_SA(b, h) (((b) * 2 + (h)) * HTB)
#define PG8_SB(b, h) ((4 + (b) * 2 + (h)) * HTB)
#define PG8_STAGE(bufoff, gbase, voff) do { _Pragma("unroll") for (int _i = 0; _i < 2; ++_i) \
        __builtin_amdgcn_global_load_lds((const unsigned*)((const char*)(gbase) + (voff)[_i]), (LAS unsigned*)(lds + (bufoff) + ldsw + _i * 8192), 16, 0, 0); } while (0)
#define PG8_LDA(dst, b, h) do { _Pragma("unroll") for (int m = 0; m < 4; ++m) _Pragma("unroll") for (int k = 0; k < 2; ++k) dst[m][k] = *(const LAS bf16x8*)(lds + PG8_SA(b, h) + aoff + m * 2048 + k * 1024); } while (0)
#define PG8_LDB(dst, b, h) do { _Pragma("unroll") for (int n = 0; n < 2; ++n) _Pragma("unroll") for (int k = 0; k < 2; ++k) dst[n][k] = *(const LAS bf16x8*)(lds + PG8_SB(b, h) + boff + n * 2048 + k * 1024); } while (0)
#define PG8_MMA(ai, bj, At, Bt) do { __builtin_amdgcn_s_setprio(1); _Pragma("unroll") for (int m = 0; m < 4; ++m) _Pragma("unroll") for (int n = 0; n < 2; ++n) _Pragma("unroll") for (int k = 0; k < 2; ++k) \
        acc[ai][bj][m][n] = SWAP ? __builtin_amdgcn_mfma_f32_16x16x32_bf16(Bt[n][k], At[m][k], acc[ai][bj][m][n], 0, 0, 0) \
                                 : __builtin_amdgcn_mfma_f32_16x16x32_bf16(At[m][k], Bt[n][k], acc[ai][bj][m][n], 0, 0, 0); __builtin_amdgcn_s_setprio(0); } while (0)
#define PG8_WAIT_V(n) asm volatile("s_waitcnt vmcnt(" #n ")" ::: "memory")
#define PG8_WAIT_L(n) asm volatile("s_waitcnt lgkmcnt(" #n ")" ::: "memory")
#define PG8_BAR __builtin_amdgcn_s_barrier()
#define PG8_SCHED __builtin_amdgcn_sched_barrier(0)
#define PG8_APTR(p0, p1, tt) ((ksplit >= nt || (tt) < ksplit) ? (p0) + (size_t)(tt) * kstep : (p1) + (size_t)((tt) - ksplit) * kstep)
    Unit cur, nxt; int ui = 0;
    if (!S.next(0, cur)) return;
    f32x4 acc[2][2][4][2];
#pragma unroll
    for (int a = 0; a < 2; ++a)
#pragma unroll
        for (int b = 0; b < 2; ++b)
#pragma unroll
            for (int m = 0; m < 4; ++m)
#pragma unroll
                for (int n = 0; n < 2; ++n) acc[a][b][m][n] = (f32x4){0.f, 0.f, 0.f, 0.f};
    bf16x8 At[4][2], B0[2][2], B1[2][2];
    const char* cA = (const char*)g.A + (size_t)cur.pm * tstepA + cur.aoff; const char* cA1 = (const char*)g.A1 + (size_t)cur.pm * tstepA;
    const char* cB = (const char*)g.Bt + (size_t)cur.pn * tstepB;
    PG8_STAGE(PG8_SB(0, 0), cB, voffB); PG8_STAGE(PG8_SB(0, 1), cB + hstepB, voffB); PG8_STAGE(PG8_SA(0, 0), cA, voffA); PG8_STAGE(PG8_SA(0, 1), cA + hstepA, voffA);
    if (wr == 1) PG8_BAR;
    PG8_WAIT_V(2); PG8_BAR;
    PG8_STAGE(PG8_SB(1, 0), cB + kstep, voffB); PG8_STAGE(PG8_SA(1, 0), cA + kstep, voffA); PG8_STAGE(PG8_SB(1, 1), cB + hstepB + kstep, voffB);
    PG8_WAIT_V(6); PG8_BAR;
    for (;;) {
        const bool has_next = S.next(ui + 1, nxt);
        const char* nA = has_next ? (const char*)g.A + (size_t)nxt.pm * tstepA + nxt.aoff : cA; const char* nA1 = has_next ? (const char*)g.A1 + (size_t)nxt.pm * tstepA : cA1;
        const char* nB = has_next ? (const char*)g.Bt + (size_t)nxt.pn * tstepB : cB;
#pragma unroll 1
        for (int t = 0; t < nt; t += 2) {
            const bool last = (t == nt - 2);
            const char* a1 = PG8_APTR(cA, cA1, t + 1);
            const char* a2 = last ? nA : PG8_APTR(cA, cA1, t + 2); const char* b2 = last ? nB : cB + (size_t)(t + 2) * kstep;
            const char* a3 = last ? nA + kstep : PG8_APTR(cA, cA1, t + 3); const char* b3 = b2 + kstep;
            PG8_LDB(B0, 0, 0); PG8_LDB(B1, 0, 1); PG8_SCHED; PG8_LDA(At, 0, 0); PG8_STAGE(PG8_SA(1, 1), a1 + hstepA, voffA);
            PG8_WAIT_V(8); PG8_WAIT_L(0); PG8_BAR; PG8_MMA(0, 0, At, B0); PG8_MMA(0, 1, At, B1); PG8_BAR; PG8_SCHED;
            PG8_LDA(At, 0, 1); PG8_STAGE(PG8_SB(0, 0), b2, voffB); PG8_STAGE(PG8_SB(0, 1), b2 + hstepB, voffB); PG8_STAGE(PG8_SA(0, 0), a2, voffA);
            PG8_WAIT_V(8); PG8_WAIT_L(0); PG8_BAR; PG8_MMA(1, 0, At, B0); PG8_MMA(1, 1, At, B1); PG8_BAR; PG8_SCHED;
            PG8_LDB(B0, 1, 0); PG8_LDB(B1, 1, 1); PG8_SCHED; PG8_LDA(At, 1, 0); PG8_STAGE(PG8_SA(0, 1), a2 + hstepA, voffA);
            PG8_WAIT_V(8); PG8_WAIT_L(0); PG8_BAR; PG8_MMA(0, 0, At, B0); PG8_MMA(0, 1, At, B1); PG8_BAR; PG8_SCHED;
            PG8_LDA(At, 1, 1); PG8_STAGE(PG8_SB(1, 0), b3, voffB); PG8_STAGE(PG8_SB(1, 1), b3 + hstepB, voffB); PG8_STAGE(PG8_SA(1, 0), a3, voffA);
            PG8_WAIT_V(8); PG8_WAIT_L(0); PG8_BAR; PG8_MMA(1, 0, At, B0); PG8_MMA(1, 1, At, B1); PG8_BAR; PG8_SCHED;
        }
        if (wr == 0) PG8_BAR;
        E(acc, cur, wr, wc, fr, fq);
        if (!has_next) break;
#pragma unroll
        for (int a = 0; a < 2; ++a)
#pragma unroll
            for (int b = 0; b < 2; ++b)
#pragma unroll
                for (int m = 0; m < 4; ++m)
#pragma unroll
                    for (int n = 0; n < 2; ++n) acc[a][b][m][n] = (f32x4){0.f, 0.f, 0.f, 0.f};
        cur = nxt; cA = nA; cA1 = nA1; cB = nB; ++ui;
        if (wr == 1) PG8_BAR;
    }
    PG8_WAIT_V(0);
    PG8_BAR;
#undef PG8_SA
#undef PG8_SB
#undef PG8_STAGE
#undef PG8_LDA
#undef PG8_LDB
#undef PG8_MMA
#undef PG8_WAIT_V
#undef PG8_WAIT_L
#undef PG8_BAR
#undef PG8_SCHED
#undef PG8_APTR
}

template <int MODE> struct EpiRow {
    static constexpr bool PERM = true;
    bf16_t* O; int ldc; const float* ssq; const float* gn;
    __device__ __forceinline__ void operator()(const f32x4 (&acc)[2][2][4][2], const Unit& u, int wr, int wc, int fr, int fq) const {
        const int row0 = u.pm * BM + wr * 64 + fr; const int colt = u.pn * BM;
        int dcol = colt;
        if (MODE == 3) dcol = (colt < 1024) ? 3072 + colt : colt;
        const bool ycpart = (MODE == 3) && (colt < 1024);
        f32x4 gg[2][2];
        if (MODE == 3) {
#pragma unroll
            for (int bj = 0; bj < 2; ++bj) { const int cy = (ycpart ? colt : 0) + bj * HALF + wc * 32 + 8 * fq; gg[bj][0] = *(const f32x4*)(gn + cy); gg[bj][1] = *(const f32x4*)(gn + cy + 4); } }
#pragma unroll
        for (int ai = 0; ai < 2; ++ai)
#pragma unroll
            for (int mh = 0; mh < 2; ++mh) {
                u32x4 old[2][2]; f32x4 sq[2][2];
                if (MODE == 2 || MODE == 3) {
#pragma unroll
                    for (int m2 = 0; m2 < 2; ++m2) { const int row = row0 + ai * HALF + (2 * mh + m2) * 16;
#pragma unroll
                        for (int bj = 0; bj < 2; ++bj) old[m2][bj] = *(const u32x4*)(O + (size_t)row * ldc + dcol + bj * HALF + wc * 32 + 8 * fq);
                        if (MODE == 3) { const int head = ycpart ? (colt >> 8) : 0;
                            sq[m2][0] = *(const f32x4*)(ssq + ((size_t)row * 4 + head) * 8); sq[m2][1] = *(const f32x4*)(ssq + ((size_t)row * 4 + head) * 8 + 4); } }
                    __builtin_amdgcn_sched_barrier(0); }
#pragma unroll
                for (int m2 = 0; m2 < 2; ++m2) { const int m = 2 * mh + m2; const int row = row0 + ai * HALF + m * 16;
                    float rstd = 1.0f;
                    if (MODE == 3) rstd = __builtin_amdgcn_rsqf((sq[m2][0][0] + sq[m2][0][1] + sq[m2][0][2] + sq[m2][0][3] + sq[m2][1][0] + sq[m2][1][1] + sq[m2][1][2] + sq[m2][1][3]) * (1.0f / 256.0f) + EPS);
#pragma unroll
                    for (int bj = 0; bj < 2; ++bj) {
                        const int cin = bj * HALF + wc * 32 + 8 * fq;
                        bf16_t* p = O + (size_t)row * ldc + dcol + cin;
                        f32x4 v0 = acc[ai][bj][m][0], v1 = acc[ai][bj][m][1];
                        if (MODE == 1) {
#pragma unroll
                            for (int j = 0; j < 4; ++j) { v0[j] = silu_f(v0[j]); v1[j] = silu_f(v1[j]); } }
                        if (MODE == 2) { const u32x4 o = old[m2][bj];
                            v0[0] *= bflo(o.x); v0[1] *= bfhi(o.x); v0[2] *= bflo(o.y); v0[3] *= bfhi(o.y); v1[0] *= bflo(o.z); v1[1] *= bfhi(o.z); v1[2] *= bflo(o.w); v1[3] *= bfhi(o.w); }
                        if (MODE == 3) { const u32x4 o = old[m2][bj];
                            float y[8] = {bflo(o.x), bfhi(o.x), bflo(o.y), bfhi(o.y), bflo(o.z), bfhi(o.z), bflo(o.w), bfhi(o.w)};
                            if (ycpart) {
#pragma unroll
                                for (int j = 0; j < 4; ++j) { y[j] *= rstd * gg[bj][0][j]; y[4 + j] *= rstd * gg[bj][1][j]; } }
#pragma unroll
                            for (int j = 0; j < 4; ++j) { v0[j] = silu_f(v0[j]) * y[j]; v1[j] = silu_f(v1[j]) * y[4 + j]; } }
                        u32x4 w; w.x = cvt_pk_bf16_asm(v0[0], v0[1]); w.y = cvt_pk_bf16_asm(v0[2], v0[3]); w.z = cvt_pk_bf16_asm(v1[0], v1[1]); w.w = cvt_pk_bf16_asm(v1[2], v1[3]);
                        *(u32x4*)p = w; } }
                if (MODE == 2 || MODE == 3) __builtin_amdgcn_sched_barrier(0); }
    }
};
struct EpiVBlk {
    static constexpr bool PERM = false;
    bf16_t* O; int NC;
    __device__ __forceinline__ void operator()(const f32x4 (&acc)[2][2][4][2], const Unit& u, int wr, int wc, int fr, int fq) const {
#pragma unroll
        for (int ai = 0; ai < 2; ++ai)
#pragma unroll
            for (int bj = 0; bj < 2; ++bj)
#pragma unroll
                for (int n = 0; n < 2; ++n) { const int C = u.pn * BM + bj * HALF + wc * 32 + n * 16 + fr;
#pragma unroll
                    for (int i = 0; i < 2; ++i) { const int grp = u.pm * 8 + ai * 4 + wr * 2 + i;
                        const f32x4 v0 = acc[ai][bj][2 * i][n], v1 = acc[ai][bj][2 * i + 1][n];
                        u32x4 w; w.x = cvt_pk_bf16_asm(v0[0], v0[1]); w.y = cvt_pk_bf16_asm(v0[2], v0[3]); w.z = cvt_pk_bf16_asm(v1[0], v1[1]); w.w = cvt_pk_bf16_asm(v1[2], v1[3]);
                        *(u32x4*)(O + ((size_t)grp * NC + C) * 32 + fq * 8) = w; } }
    }
};
struct EpiOut {
    static constexpr bool PERM = true;
    const float* resid; float* out; const float* gate;
    __device__ __forceinline__ void operator()(const f32x4 (&acc)[2][2][4][2], const Unit& u, int wr, int wc, int fr, int fq) const {
        const int row0 = u.pm * BM + wr * 64 + fr, col0 = u.pn * BM + wc * 32 + 8 * fq;
        const int b = (u.pm * BM) >> 11;
        f32x4 gv[2][2];
#pragma unroll
        for (int bj = 0; bj < 2; ++bj)
#pragma unroll
            for (int n = 0; n < 2; ++n) gv[bj][n] = *(const f32x4*)(gate + (size_t)b * 3072 + col0 + bj * HALF + n * 4);
#pragma unroll
        for (int ai = 0; ai < 2; ++ai) { f32x4 r[4][2][2];
#pragma unroll
            for (int m = 0; m < 4; ++m) { const size_t ro = (size_t)(row0 + ai * HALF + m * 16) * D + col0;
#pragma unroll
                for (int bj = 0; bj < 2; ++bj)
#pragma unroll
                    for (int n = 0; n < 2; ++n) r[m][bj][n] = *(const f32x4*)(resid + ro + bj * HALF + n * 4); }
            __builtin_amdgcn_sched_barrier(0);
#pragma unroll
            for (int m = 0; m < 4; ++m) { const size_t ro = (size_t)(row0 + ai * HALF + m * 16) * D + col0;
#pragma unroll
                for (int bj = 0; bj < 2; ++bj)
#pragma unroll
                    for (int n = 0; n < 2; ++n) *(f32x4*)(out + ro + bj * HALF + n * 4) = r[m][bj][n] + gv[bj][n] * acc[ai][bj][m][n]; }
            __builtin_amdgcn_sched_barrier(0); }
    }
};
}

struct Args { const float* in[18]; float* out; unsigned char* ws; int ph_lo, ph_hi; };
enum { I_X = 0, I_C, I_ADAW, I_ADAB, I_NORMG, I_EINW, I_POOLW, I_POOLS, I_SGUG, I_SGUW, I_SGUB, I_EOUTW, I_OINW, I_GGW, I_GGB, I_GNG, I_OOUTW, I_FG };

__device__ __forceinline__ void transpose_tile(int wv, LAS float* tile, const float* src, int ld, int col0, int k0, bf16_t* dst, int ldd, int row0, const float* scale) {
    const int tid = opaque_tid(wv);
    { const int r = tid >> 4, c4 = tid & 15; f32x4 v[4];
#pragma unroll
      for (int i = 0; i < 4; ++i) v[i] = *(const f32x4*)(src + (size_t)(k0 + r + 32 * i) * ld + col0 + c4 * 4);
#pragma unroll
      for (int i = 0; i < 4; ++i)
#pragma unroll
          for (int j = 0; j < 4; ++j) tile[(r + 32 * i) * 65 + c4 * 4 + j] = v[i][j]; }
    __syncthreads();
    { const int n = tid >> 3, kc = (tid & 7) * 16; const float s = scale ? scale[n] : 1.0f;
#pragma unroll
      for (int h = 0; h < 2; ++h) { f32x4 a, b;
#pragma unroll
          for (int j = 0; j < 4; ++j) { a[j] = tile[(kc + 8 * h + j) * 65 + n] * s; b[j] = tile[(kc + 8 * h + 4 + j) * 65 + n] * s; }
          *(bf16x8*)(dst + (size_t)(row0 + n) * ldd + k0 + kc + 8 * h) = pack8(a, b); } }
    __syncthreads();
}

__device__ void phase_prep(int wv, const Args& a, LAS float* lds) {
    const int tid = opaque_tid(wv); unsigned char* ws = a.ws;
    for (int job = blockIdx.x; job < 192; job += gridDim.x) {
        {
            const int l = job / 96, cb = job % 96;
            LAS float* sc = lds; LAS float* red = lds + 16384;
            for (int i = tid; i < 16384; i += 512) sc[i] = silu_f(a.in[I_C][i]);
            __syncthreads();
            const int col = tid & 31, kg = tid >> 5;
            float acc[16];
#pragma unroll
            for (int b = 0; b < 16; ++b) acc[b] = 0.f;
            const float* w = a.in[I_ADAW] + (size_t)l * 1024 * 3072 + cb * 32 + col;
            for (int kk0 = 0; kk0 < 64; kk0 += 8) { float wv8[8];
#pragma unroll
                for (int u = 0; u < 8; ++u) wv8[u] = w[(size_t)(kg * 64 + kk0 + u) * 3072];
#pragma unroll
                for (int u = 0; u < 8; ++u) { const int k = kg * 64 + kk0 + u;
#pragma unroll
                    for (int b = 0; b < 16; ++b) acc[b] += sc[b * 1024 + k] * wv8[u]; } }
#pragma unroll
            for (int b = 0; b < 16; ++b) red[(kg * 16 + b) * 32 + col] = acc[b];
            __syncthreads();
            { const int b = tid >> 5; float s = a.in[I_ADAB][l * 3072 + cb * 32 + col];
#pragma unroll
              for (int q = 0; q < 16; ++q) s += red[(q * 16 + b) * 32 + col];
              ((float*)(ws + WS_ADA))[((size_t)l * 16 + b) * 3072 + cb * 32 + col] = s; }
            __syncthreads();
        }
    }
    struct TJob { const float* src; bf16_t* dst; const float* scale; int ld, col0, k0, ldd, row0; };
    auto decode = [&](int t) -> TJob {
        TJob j;
        if (t < 640) { const int nt = t / 8, kt = t % 8; j = TJob{a.in[I_EINW], (bf16_t*)(ws + WS_IN0T), nullptr, 5120, nt * 64, kt * 128, 1024, nt * 64}; }
        else if ((t -= 640) < 256) { const int nt = t / 16, kt = t % 16; j = TJob{a.in[I_EOUTW], (bf16_t*)(ws + WS_OUT0T), nullptr, 1024, nt * 64, kt * 128, 2048, nt * 64}; }
        else if ((t -= 256) < 896) { const int nt = t / 8, kt = t % 8; const int r0 = nt * 64;
            const int sc = r0 < 1024 ? r0 : r0 < 3072 ? 2064 + (r0 - 1024) : r0 < 4096 ? 1024 + (r0 - 3072) : r0 < 5120 ? 4112 + (r0 - 4096) : 5136 + (r0 - 5120);
            j = TJob{a.in[I_OINW], (bf16_t*)(ws + WS_IN1T), nullptr, 7184, sc, kt * 128, 1024, r0}; }
        else if ((t -= 896) < 256) { const int nt = t / 16, kt = t % 16; j = TJob{a.in[I_OOUTW], (bf16_t*)(ws + WS_OUT1T), nullptr, 1024, nt * 64, kt * 128, 2048, nt * 64}; }
        else { t -= 256; const int g = t >> 3, dt = (t >> 1) & 3, ct = t & 1;
            j = TJob{a.in[I_POOLW] + (size_t)g * 65536, (bf16_t*)(ws + WS_POOLT), a.in[I_POOLS] + g * 256 + dt * 64, 256, dt * 64, ct * 128, 256, g * 256 + dt * 64}; }
        return j; };
    {
        const int r = tid >> 4, c4 = tid & 15, n = tid >> 3, kc = (tid & 7) * 16;
        f32x4 v[4];
        int t = (int)((blockIdx.x + 64u) % gridDim.x);
        TJob cj = decode(t < 2080 ? t : 0);
        if (t < 2080) {
#pragma unroll
            for (int i = 0; i < 4; ++i) v[i] = *(const f32x4*)(cj.src + (size_t)(cj.k0 + r + 32 * i) * cj.ld + cj.col0 + c4 * 4); }
        for (; t < 2080; t += gridDim.x) {
#pragma unroll
            for (int i = 0; i < 4; ++i)
#pragma unroll
                for (int j = 0; j < 4; ++j) lds[(r + 32 * i) * 65 + c4 * 4 + j] = v[i][j];
            __syncthreads();
            const TJob pj = cj;
            const int tn = t + (int)gridDim.x;
            if (tn < 2080) { cj = decode(tn);
#pragma unroll
                for (int i = 0; i < 4; ++i) v[i] = *(const f32x4*)(cj.src + (size_t)(cj.k0 + r + 32 * i) * cj.ld + cj.col0 + c4 * 4); }
            const float s = pj.scale ? pj.scale[n] : 1.0f;
#pragma unroll
            for (int h = 0; h < 2; ++h) { f32x4 x, y;
#pragma unroll
                for (int j = 0; j < 4; ++j) { x[j] = lds[(kc + 8 * h + j) * 65 + n] * s; y[j] = lds[(kc + 8 * h + 4 + j) * 65 + n] * s; }
                *(bf16x8*)(pj.dst + (size_t)(pj.row0 + n) * pj.ldd + pj.k0 + kc + 8 * h) = pack8(x, y); }
            __syncthreads();
        }
    }
    float* sw = (float*)(ws + WS_SGUW);
    for (int i = blockIdx.x * 512 + tid; i < 8 * 128 * 128; i += gridDim.x * 512) { const int s = i & 127, t = (i >> 7) & 127; sw[i] = (s <= t) ? a.in[I_SGUW][i] : 0.f; }
}

__device__ void phase_h(int wv, const float* xin, const float* normg, const float* ada, bf16_t* H, bool with_glr, const float* oinw, float* GLR, LAS float* lds) {
    const int tid = opaque_tid(wv), lane = tid & 63, wave = tid >> 6;
    if (with_glr) { for (int i = tid; i < 16384; i += 512) { const int c = i >> 4, j = i & 15; lds[j * 1024 + c] = oinw[(size_t)c * 7184 + 2048 + j]; } __syncthreads(); }
    f32x4 gh[4];
#pragma unroll
    for (int i = 0; i < 4; ++i) gh[i] = *(const f32x4*)(normg + i * 256 + lane * 4);
    for (int r0 = (blockIdx.x * 8 + wave) * 2; r0 < M; r0 += gridDim.x * 16) {
        f32x4 xr[2][4], sc4[4], sh4[4];
        { const float* ab0 = ada + (size_t)(r0 >> 11) * 3072;
#pragma unroll
          for (int i = 0; i < 4; ++i) { sc4[i] = *(const f32x4*)(ab0 + 1024 + i * 256 + lane * 4); sh4[i] = *(const f32x4*)(ab0 + i * 256 + lane * 4); } }
#pragma unroll
        for (int u = 0; u < 2; ++u)
#pragma unroll
            for (int i = 0; i < 4; ++i) xr[u][i] = *(const f32x4*)(xin + (size_t)(r0 + u) * D + i * 256 + lane * 4);
        __builtin_amdgcn_sched_barrier(0);
#pragma unroll
        for (int u = 0; u < 2; ++u) {
        const int r = r0 + u;
        const int b = r >> 11; const float* ab = ada + (size_t)b * 3072;
        f32x4 x4[4]; float ssq = 0.f;
#pragma unroll
        for (int i = 0; i < 4; ++i) { x4[i] = xr[u][i]; ssq += x4[i][0] * x4[i][0] + x4[i][1] * x4[i][1] + x4[i][2] * x4[i][2] + x4[i][3] * x4[i][3]; }
        ssq = wave_sum(ssq);
        const float rstd = __builtin_amdgcn_rsqf(ssq * (1.0f / 1024.0f) + EPS);
#pragma unroll
        for (int i = 0; i < 4; ++i) { const int c = i * 256 + lane * 4;
            x4[i] = x4[i] * rstd * gh[i] * (sc4[i] + 1.0f) + sh4[i];
            u32x2 w; w.x = cvt_pk_bf16(x4[i][0], x4[i][1]); w.y = cvt_pk_bf16(x4[i][2], x4[i][3]);
            *(u32x2*)(H + (size_t)r * D + c) = w; }
        if (with_glr) {
            float v[16]; int lo = lane * 4; asm volatile("" : "+v"(lo));
#pragma unroll
            for (int qg = 0; qg < 8; ++qg) { f32x4 wq[2][4];
#pragma unroll
                for (int qq = 0; qq < 2; ++qq)
#pragma unroll
                    for (int i = 0; i < 4; ++i) wq[qq][i] = *(const LAS f32x4*)(lds + (2 * qg + qq) * 1024 + i * 256 + lo);
                __builtin_amdgcn_sched_barrier(0);
#pragma unroll
                for (int qq = 0; qq < 2; ++qq) { float s = 0.f;
#pragma unroll
                    for (int i = 0; i < 4; ++i) s += x4[i][0] * wq[qq][i][0] + x4[i][1] * wq[qq][i][1] + x4[i][2] * wq[qq][i][2] + x4[i][3] * wq[qq][i][3];
                    v[2 * qg + qq] = s; }
                __builtin_amdgcn_sched_barrier(0); }
#define GLR_STEP(NN, MASK) do { float rcv[NN]; const bool up = (lane & (MASK)) != 0; \
                _Pragma("unroll") for (int i = 0; i < (NN); ++i) { const float lo_ = v[i], hi_ = v[i + (NN)]; rcv[i] = __shfl_xor(up ? lo_ : hi_, (MASK)); } \
                _Pragma("unroll") for (int i = 0; i < (NN); ++i) { const float lo_ = v[i], hi_ = v[i + (NN)]; v[i] = (up ? hi_ : lo_) + rcv[i]; } } while (0)
            GLR_STEP(8, 32); GLR_STEP(4, 16); GLR_STEP(2, 8); GLR_STEP(1, 4);
#undef GLR_STEP
            v[0] += __shfl_xor(v[0], 2); v[0] += __shfl_xor(v[0], 1);
            if ((lane & 3) == 0) GLR[(size_t)r * 16 + (lane >> 2)] = v[0];
        }
        }
    }
    __syncthreads();
}

__device__ void phase_poolp(int wv, const bf16_t* AU, bf16_t* P) {
    const int gid = blockIdx.x * 512 + opaque_tid(wv), stride = gridDim.x * 512;
    for (int job = gid; job < (M / 8) * 128; job += stride) {
        const int c8 = job & 127, seg = job >> 7, T0 = seg * 8, col = c8 * 8, g = col >> 8, w = 2 << g, tin = T0 & 2047;
        const bf16_t* base = AU + (size_t)T0 * 2048 + col;
        const u32x4 zero = {0u, 0u, 0u, 0u};
        u32x4 prev[15], curv[8], oldv[8];
#pragma unroll
        for (int i = 1; i < 16; ++i) { const bool ok = (i < w && tin - i >= 0); prev[i - 1] = *(const u32x4*)(base - (ptrdiff_t)(ok ? i : 0) * 2048); }
#pragma unroll
        for (int tt = 0; tt < 8; ++tt) curv[tt] = *(const u32x4*)(base + (size_t)tt * 2048);
        oldv[0] = zero;
#pragma unroll
        for (int tt = 1; tt < 8; ++tt) { const bool ok = (tin + tt - w >= 0); oldv[tt] = *(const u32x4*)(base + (ptrdiff_t)(ok ? tt - w : 0) * 2048); }
        __builtin_amdgcn_sched_barrier(0);
        float sum[8];
#pragma unroll
        for (int j = 0; j < 8; ++j) sum[j] = 0.f;
#pragma unroll
        for (int i = 0; i < 15; ++i) { const u32x4 v = prev[i]; const float mk = ((i + 1) < w && tin - (i + 1) >= 0) ? 1.0f : 0.0f;
            sum[0] += mk * bflo(v.x); sum[1] += mk * bfhi(v.x); sum[2] += mk * bflo(v.y); sum[3] += mk * bfhi(v.y); sum[4] += mk * bflo(v.z); sum[5] += mk * bfhi(v.z); sum[6] += mk * bflo(v.w); sum[7] += mk * bfhi(v.w); }
#pragma unroll
        for (int tt = 0; tt < 8; ++tt) { const int pos = tin + tt;
            const u32x4 v = curv[tt];
            const float cur[8] = {bflo(v.x), bfhi(v.x), bflo(v.y), bfhi(v.y), bflo(v.z), bfhi(v.z), bflo(v.w), bfhi(v.w)};
#pragma unroll
            for (int j = 0; j < 8; ++j) sum[j] += cur[j];
            { const u32x4 o = oldv[tt]; const float mk = (tt > 0 && tin + tt - w >= 0) ? 1.0f : 0.0f;
              sum[0] -= mk * bflo(o.x); sum[1] -= mk * bfhi(o.x); sum[2] -= mk * bflo(o.y); sum[3] -= mk * bfhi(o.y); sum[4] -= mk * bflo(o.z); sum[5] -= mk * bfhi(o.z); sum[6] -= mk * bflo(o.w); sum[7] -= mk * bfhi(o.w); }
            const float inv = 1.0f / (float)(pos + 1 < w ? pos + 1 : w);
            u32x4 o; o.x = cvt_pk_bf16(sum[0] * inv - cur[0], sum[1] * inv - cur[1]); o.y = cvt_pk_bf16(sum[2] * inv - cur[2], sum[3] * inv - cur[3]);
            o.z = cvt_pk_bf16(sum[4] * inv - cur[4], sum[5] * inv - cur[5]); o.w = cvt_pk_bf16(sum[6] * inv - cur[6], sum[7] * inv - cur[7]);
            *(u32x4*)(P + (size_t)(T0 + tt) * 1024 + col) = o; }
    }
}

__device__ void phase_sgu(int wv, const bf16_t* AU, const bf16_t* V0, bf16_t* Y0, const float* SGUW, const float* sgub, const float* sgug, LAS float* lds) {
    const int tid = opaque_tid(wv), lane = tid & 63, hh = tid >> 6, fr = lane & 15, fq = lane >> 4;
    for (int chunk = blockIdx.x; chunk < M / 128; chunk += gridDim.x) {
        const int tok0 = chunk * 128;
        {
          const int g = tid >> 7, kq = (tid >> 5) & 3, j = tid & 31;
          const bf16_t* vp = V0 + ((size_t)((tok0 >> 5) + g) * 1024 + j) * 32 + kq * 8;
          float ac[8];
#pragma unroll
          for (int e = 0; e < 8; ++e) ac[e] = 0.f;
          for (int ib = 0; ib < 4; ++ib) { u32x4 vv[8];
#pragma unroll
              for (int i = 0; i < 8; ++i) vv[i] = *(const u32x4*)(vp + (size_t)(8 * ib + i) * 32 * 32);
              __builtin_amdgcn_sched_barrier(0);
#pragma unroll
              for (int i = 0; i < 8; ++i) { const u32x4 v = vv[i];
                  const float f0 = bflo(v.x), f1 = bfhi(v.x), f2 = bflo(v.y), f3 = bfhi(v.y), f4 = bflo(v.z), f5 = bfhi(v.z), f6 = bflo(v.w), f7 = bfhi(v.w);
                  ac[0] += f0 * f0; ac[1] += f1 * f1; ac[2] += f2 * f2; ac[3] += f3 * f3; ac[4] += f4 * f4; ac[5] += f5 * f5; ac[6] += f6 * f6; ac[7] += f7 * f7; } }
#pragma unroll
          for (int e = 0; e < 8; ++e) {
#pragma unroll
              for (int m = 16; m >= 1; m >>= 1) ac[e] += __shfl_xor(ac[e], m); }
          if (j == 0) {
#pragma unroll
              for (int e = 0; e < 8; ++e) lds[32 * g + 16 * (e >> 2) + 4 * kq + (e & 3)] = __builtin_amdgcn_rsqf(ac[e] * (1.0f / 1024.0f) + EPS); } }
        __syncthreads();
        f32x4 gsg[8];
#pragma unroll
        for (int n = 0; n < 8; ++n) gsg[n] = *(const f32x4*)(sgug + hh * 128 + 16 * n + 4 * fq);
        for (int mp = 0; mp < 4; ++mp) {
            f32x4 acc[2][8];
#pragma unroll
            for (int i = 0; i < 2; ++i)
#pragma unroll
                for (int n = 0; n < 8; ++n) acc[i][n] = (f32x4){0.f, 0.f, 0.f, 0.f};
            for (int ks = 0; ks <= mp; ++ks) {
                const int s0 = 32 * ks + 4 * fq;
                bf16x8 bfv[8];
#pragma unroll
                for (int n = 0; n < 8; ++n) bfv[n] = *(const bf16x8*)(V0 + ((size_t)((tok0 >> 5) + ks) * 1024 + hh * 128 + 16 * n + fr) * 32 + fq * 8);
                const f32x4 ra = *(const LAS f32x4*)(lds + s0), rb = *(const LAS f32x4*)(lds + s0 + 16);
                f32x4 wl[2][2];
#pragma unroll
                for (int i = 0; i < 2; ++i) { const float* wrow = SGUW + ((size_t)hh * 128 + 16 * (2 * mp + i) + fr) * 128; wl[i][0] = *(const f32x4*)(wrow + s0); wl[i][1] = *(const f32x4*)(wrow + s0 + 16); }
                __builtin_amdgcn_sched_barrier(0);
                bf16x8 af[2];
#pragma unroll
                for (int i = 0; i < 2; ++i) af[i] = pack8(wl[i][0] * ra, wl[i][1] * rb);
#pragma unroll
                for (int n = 0; n < 8; ++n) { acc[0][n] = MFMA16(bfv[n], af[0], acc[0][n]); acc[1][n] = MFMA16(bfv[n], af[1], acc[1][n]); }
            }
#pragma unroll
            for (int i = 0; i < 2; ++i) { const int t = 16 * (2 * mp + i) + fr; const float bb = sgub[hh * 128 + t];
                u32x2 uu[8], GG[8];
#pragma unroll
                for (int n = 0; n < 8; ++n) { const int col = hh * 128 + 16 * n + 4 * fq;
                    uu[n] = *(const u32x2*)(AU + (size_t)(tok0 + t) * 2048 + 1024 + col); GG[n] = *(const u32x2*)(Y0 + (size_t)(tok0 + t) * 2048 + 1024 + col); }
                __builtin_amdgcn_sched_barrier(0);
#pragma unroll
                for (int n = 0; n < 8; ++n) { const int col = hh * 128 + 16 * n + 4 * fq;
                    const f32x4 g = gsg[n];
                    bf16_t* yp = Y0 + (size_t)(tok0 + t) * 2048 + 1024 + col;
                    const u32x2 u = uu[n], G = GG[n];
                    const f32x4 z = acc[i][n] * g + bb;
                    u32x2 o; o.x = cvt_pk_bf16(z[0] * bflo(u.x) * bflo(G.x), z[1] * bfhi(u.x) * bfhi(G.x)); o.y = cvt_pk_bf16(z[2] * bflo(u.y) * bflo(G.y), z[3] * bfhi(u.y) * bfhi(G.y));
                    *(u32x2*)yp = o; } }
        }
        __syncthreads();
    }
}

typedef short s16x4 __attribute__((ext_vector_type(4)));
constexpr int GP_GLR = 0, GP_TOT = 4096;
__device__ void phase_glapre(int wv, bf16_t* QK, const float* GLR, float* EB, const float* ggw, const float* ggb, LAS unsigned char* lds) {
    const int tid = opaque_tid(wv);
    LAS float* sGLR = (LAS float*)(lds + GP_GLR); LAS float* sTOT = (LAS float*)(lds + GP_TOT);
    const int k = tid & 127, sq = tid >> 7;
    f32x4 pg = (f32x4){0.f, 0.f, 0.f, 0.f}; unsigned short pq[16], pkk[16];
#define GP_LOAD(itt) do { const int _b = (itt) >> 7, _hh = ((itt) >> 5) & 3, _n = (itt) & 31, _t0 = _b * 2048 + _n * 64; \
        if (tid < 256) pg = *(const f32x4*)(GLR + (size_t)_t0 * 16 + tid * 4); \
        _Pragma("unroll") for (int i = 0; i < 16; ++i) { const size_t ro = (size_t)(_t0 + 16 * sq + i) * 4096 + _hh * 128 + k; pq[i] = QK[ro]; pkk[i] = QK[ro + 512]; } } while (0)
    if ((int)blockIdx.x < 2048) GP_LOAD((int)blockIdx.x);
    float gw[16], gb = 0.f; int hh_ld = -1;
#pragma unroll
    for (int j = 0; j < 16; ++j) gw[j] = 0.f;
    for (int it = blockIdx.x; it < 2048; it += gridDim.x) {
        const int b = it >> 7, hh = (it >> 5) & 3, n = it & 31, col = hh * 128 + k, tok0 = b * 2048 + n * 64;
        if (hh != hh_ld) { hh_ld = hh;
#pragma unroll
            for (int j = 0; j < 16; ++j) gw[j] = ggw[j * 512 + col];
            gb = ggb[col]; }
        if (tid < 256) *(LAS f32x4*)(sGLR + tid * 4) = pg;
        float qv[16], kv[16];
#pragma unroll
        for (int i = 0; i < 16; ++i) { qv[i] = bf2f(pq[i]); kv[i] = bf2f(pkk[i]); }
        __syncthreads();
        if (it + (int)gridDim.x < 2048) GP_LOAD(it + (int)gridDim.x);
        float c[16]; float run = 0.f;
#pragma unroll
        for (int i = 0; i < 16; ++i) { const int s = 16 * sq + i; float dot = gb;
#pragma unroll
            for (int j4 = 0; j4 < 4; ++j4) { const f32x4 gl = *(const LAS f32x4*)(sGLR + s * 16 + j4 * 4); dot += gl[0] * gw[j4 * 4] + gl[1] * gw[j4 * 4 + 1] + gl[2] * gw[j4 * 4 + 2] + gl[3] * gw[j4 * 4 + 3]; }
            run += logsig2_f(dot * 1.4426950408889634f) * (1.0f / 16.0f); c[i] = run; }
        sTOT[sq * 128 + k] = run;
        __syncthreads();
        const float t0 = sTOT[k], t1 = sTOT[128 + k], t2 = sTOT[256 + k], t3 = sTOT[384 + k];
        const float pre = (sq > 0 ? t0 : 0.f) + (sq > 1 ? t1 : 0.f) + (sq > 2 ? t2 : 0.f), blast = t0 + t1 + t2 + t3;
#pragma unroll
        for (int i = 0; i < 16; ++i) { const size_t ro = (size_t)(tok0 + 16 * sq + i) * 4096 + col; const float bc = pre + c[i];
            QK[ro] = f2bf(qv[i] * 0.08838834764831845f * __builtin_amdgcn_exp2f(bc));
            QK[ro + 512] = f2bf(kv[i] * __builtin_amdgcn_exp2f(-bc)); }
        if (sq == 0) EB[(size_t)it * 128 + k] = __builtin_amdgcn_exp2f(blast);
        __syncthreads();
    }
#undef GP_LOAD
}

constexpr int G2_BUF = 43520, G2_QD = 0, G2_KI = 17408, G2_VT = 34816, G2_EB = 43008, G2_ST = 2 * G2_BUF, G2_STB = 17408;
__device__ void phase_gla2(int wv, const bf16_t* QK, const bf16_t* V1, bf16_t* YC  , const float* EB, float* SSQ, LAS unsigned char* lds) {
    const int tid = opaque_tid(wv), lane = tid & 63, fr = lane & 15, fq = lane >> 4;
    for (int item = blockIdx.x; item < 256; item += gridDim.x) {
        const int b = item >> 4, hh = (item >> 2) & 3, vs = item & 3;
        f32x4 S[2][4];
#pragma unroll
        for (int kk = 0; kk < 2; ++kk)
#pragma unroll
            for (int i = 0; i < 4; ++i) S[kk][i] = (f32x4){0.f, 0.f, 0.f, 0.f};
        u32x4 pqd[2], pki[2], pvv; float peb = 0.f;
#define G2_LOAD(nn) do { const int _t0 = b * 2048 + (nn) * 64; \
            _Pragma("unroll") for (int i = 0; i < 2; ++i) { const int ch = tid + 512 * i, s = ch >> 4, c16 = ch & 15; const bf16_t* p = QK + (size_t)(_t0 + s) * 4096 + hh * 128 + c16 * 8; \
                pqd[i] = *(const u32x4*)p; pki[i] = *(const u32x4*)(p + 512); } \
            { const int grp = tid >> 8, v = (tid >> 2) & 63, ch = tid & 3; pvv = *(const u32x4*)(V1 + ((size_t)((_t0 >> 5) + grp) * 2048 + hh * 256 + vs * 64 + v) * 32 + ch * 8); } \
            if (tid < 128) peb = EB[((size_t)((b * 4 + hh) * 32 + (nn))) * 128 + tid]; } while (0)
#define G2_STORE(bb) do { LAS unsigned char* _q = lds + (bb) * G2_BUF; \
            _Pragma("unroll") for (int i = 0; i < 2; ++i) { const int ch = tid + 512 * i, s = ch >> 4, c16 = ch & 15; \
                *(LAS u32x4*)((LAS bf16_t*)(_q + G2_QD) + s * 136 + c16 * 8) = pqd[i]; *(LAS u32x4*)((LAS bf16_t*)(_q + G2_KI) + s * 136 + c16 * 8) = pki[i]; } \
            { const int grp = tid >> 8, v = (tid >> 2) & 63, ch = tid & 3; *(LAS u32x4*)((LAS bf16_t*)(_q + G2_VT) + (grp * 64 + v) * 32 + ch * 8) = pvv; } \
            if (tid < 128) ((LAS float*)(_q + G2_EB))[tid] = peb; } while (0)
        G2_LOAD(0);
        __syncthreads();
        for (int i = tid; i < G2_STB / 4; i += 512) ((LAS unsigned*)(lds + G2_ST))[i] = 0u;
        G2_STORE(0);
        G2_LOAD(1);
        __syncthreads();
        for (int n = 0; n < 32; ++n) {
            const int tok0 = b * 2048 + n * 64;
            LAS unsigned char* cb = lds + (n & 1) * G2_BUF;
            LAS bf16_t* sQD = (LAS bf16_t*)(cb + G2_QD); LAS bf16_t* sKI = (LAS bf16_t*)(cb + G2_KI); LAS bf16_t* sVT = (LAS bf16_t*)(cb + G2_VT); LAS float* sEB = (LAS float*)(cb + G2_EB);
            LAS bf16_t* stR = (LAS bf16_t*)(lds + G2_ST + (n & 1) * G2_STB);
            LAS bf16_t* stW = (LAS bf16_t*)(lds + G2_ST + ((n + 1) & 1) * G2_STB);
            if (wv < 4) {
              const int tt = wv;
              bf16x8 qf[4];
#pragma unroll
              for (int ks = 0; ks < 4; ++ks) qf[ks] = *(const LAS bf16x8*)(sQD + (16 * tt + fr) * 136 + 32 * ks + 8 * fq);
              f32x4 att[4];
#pragma unroll
              for (int st = 0; st < 4; ++st) { att[st] = (f32x4){0.f, 0.f, 0.f, 0.f};
                  if (st <= tt) {
#pragma unroll
                      for (int ks = 0; ks < 4; ++ks) att[st] = MFMA16(*(const LAS bf16x8*)(sKI + (16 * st + fr) * 136 + 32 * ks + 8 * fq), qf[ks], att[st]);
                      if (st == tt) {
#pragma unroll
                          for (int r = 0; r < 4; ++r) if (4 * fq + r > fr) att[st][r] = 0.f; } } }
              const bf16x8 wf0 = pack8(att[0], att[1]), wf1 = pack8(att[2], att[3]);
              float ss = 0.f;
#pragma unroll
              for (int vt = 0; vt < 4; ++vt) { f32x4 o = (f32x4){0.f, 0.f, 0.f, 0.f};
                  o = MFMA16(*(const LAS bf16x8*)(sVT + (16 * vt + fr) * 32 + fq * 8), wf0, o);
                  o = MFMA16(*(const LAS bf16x8*)(sVT + (64 + 16 * vt + fr) * 32 + fq * 8), wf1, o);
#pragma unroll
                  for (int ks = 0; ks < 4; ++ks) o = MFMA16(*(const LAS bf16x8*)(stR + (16 * vt + fr) * 136 + 32 * ks + 8 * fq), qf[ks], o);
                  u32x2 ow; ow.x = cvt_pk_bf16(o[0], o[1]); ow.y = cvt_pk_bf16(o[2], o[3]);
                  *(u32x2*)(YC + (size_t)(tok0 + 16 * tt + fr) * 4096 + hh * 256 + vs * 64 + 16 * vt + 4 * fq) = ow;
                  ss += o[0] * o[0] + o[1] * o[1] + o[2] * o[2] + o[3] * o[3]; }
              ss += __shfl_xor(ss, 16); ss += __shfl_xor(ss, 32);
              if (lane < 16) { float* sp = SSQ + ((size_t)(tok0 + 16 * tt + fr) * 4 + hh) * 8 + vs * 2; sp[0] = ss; sp[1] = 0.f; }
            } else {
              const int kb = wv - 4;
              bf16x8 vf[2][4];
#pragma unroll
              for (int g2 = 0; g2 < 2; ++g2)
#pragma unroll
                  for (int vt = 0; vt < 4; ++vt) vf[g2][vt] = *(const LAS bf16x8*)(sVT + (64 * g2 + 16 * vt + fr) * 32 + fq * 8);
#pragma unroll
              for (int kk = 0; kk < 2; ++kk) { const int kt = 2 * kb + kk;
                  const f32x4 eb = *(const LAS f32x4*)(sEB + 16 * kt + 4 * fq);
                  bf16x8 ka[2];
#pragma unroll
                  for (int g2 = 0; g2 < 2; ++g2) {
                      const s16x4 lo = __builtin_amdgcn_ds_read_tr16_b64_v4i16((LAS s16x4*)(sKI + (32 * g2 + 4 * fq + (fr >> 2)) * 136 + 16 * kt + 4 * (fr & 3)));
                      const s16x4 hi = __builtin_amdgcn_ds_read_tr16_b64_v4i16((LAS s16x4*)(sKI + (32 * g2 + 16 + 4 * fq + (fr >> 2)) * 136 + 16 * kt + 4 * (fr & 3)));
                      ka[g2] = (bf16x8){lo[0], lo[1], lo[2], lo[3], hi[0], hi[1], hi[2], hi[3]}; }
#pragma unroll
                  for (int vt = 0; vt < 4; ++vt) {
                      S[kk][vt] = MFMA16(ka[0], vf[0][vt], S[kk][vt]);
                      S[kk][vt] = MFMA16(ka[1], vf[1][vt], S[kk][vt]);
                      S[kk][vt] = S[kk][vt] * eb;
                      u32x2 ow; ow.x = cvt_pk_bf16(S[kk][vt][0], S[kk][vt][1]); ow.y = cvt_pk_bf16(S[kk][vt][2], S[kk][vt][3]);
                      *(LAS u32x2*)(stW + (16 * vt + fr) * 136 + 16 * kt + 4 * fq) = ow; } } }
            if (n < 31) { G2_STORE((n + 1) & 1); if (n < 30) G2_LOAD(n + 2); }
            __syncthreads();
        }
#undef G2_LOAD
#undef G2_STORE
    }
}

constexpr int SB_K = 0, SB_V = 17408, SB_BUF = 16896;
__device__ void phase_sb(int wv, bf16_t* QK, const bf16_t* V1, LAS unsigned char* lds) {
    const int tid = opaque_tid(wv), lane = tid & 63, w = tid >> 6, fr = lane & 15, fq = lane >> 4;
    LAS bf16_t* sK = (LAS bf16_t*)(lds + SB_K); LAS bf16_t* sV = (LAS bf16_t*)(lds + SB_V); LAS int* sDone = (LAS int*)(lds + 2 * SB_BUF * 2); int it = 0;
    const float scale = 0.08838834764831845f * 1.4426950408889634f;
    for (int cc = blockIdx.x; cc < 256; cc += gridDim.x) {
        const int ph = cc >> 1, half = cc & 1, b = ph >> 3, hh = ph & 7;
        bf16x8 nq[4]; u32x4 nk[2], nv[2];
#define SB_QB(jj) (half ? (((jj) & 1) ? 4 + ((jj) >> 1) : 11 - ((jj) >> 1)) : (((jj) & 1) ? ((jj) >> 1) : 15 - ((jj) >> 1)))
#define SB_NEXT(jj) do { const int _qb = SB_QB(jj), _kb = 2 * _qb + 1; const size_t _qr = (size_t)(b * 2048 + 128 * _qb + 16 * w + fr) * 4096 + 1024 + hh * 128; \
            _Pragma("unroll") for (int ks = 0; ks < 4; ++ks) nq[ks] = *(const bf16x8*)(QK + _qr + 32 * ks + 8 * fq); \
            _Pragma("unroll") for (int i = 0; i < 2; ++i) { const int ch = tid + 512 * i; \
                { const int s = ch >> 4, c16 = ch & 15; nk[i] = *(const u32x4*)(QK + (size_t)(b * 2048 + 64 * _kb + s) * 4096 + 2048 + hh * 128 + c16 * 8); } \
                { const int grp = ch >> 9, d = (ch >> 2) & 127, c4 = ch & 3; nv[i] = *(const u32x4*)(V1 + ((size_t)(((b * 2048 + 64 * _kb) >> 5) + grp) * 2048 + 1024 + hh * 128 + d) * 32 + c4 * 8); } } } while (0)
        SB_NEXT(0);
        for (int j = 0; j < 8; ++j) {
            const int qb = SB_QB(j);
            const int tq = 128 * qb + 16 * w + fr;
            const size_t qrow = (size_t)(b * 2048 + tq) * 4096 + 1024 + hh * 128;
            bf16x8 qf[4];
#pragma unroll
            for (int ks = 0; ks < 4; ++ks) qf[ks] = nq[ks];
            u32x4 pk[2], pv[2];
            pk[0] = nk[0]; pk[1] = nk[1]; pv[0] = nv[0]; pv[1] = nv[1];
            if (j < 7) SB_NEXT(j + 1);
            f32x4 oacc[8];
#pragma unroll
            for (int d = 0; d < 8; ++d) oacc[d] = (f32x4){0.f, 0.f, 0.f, 0.f};
            float R = 0.f;
#define SB_LOAD(kbb) do { _Pragma("unroll") for (int i = 0; i < 2; ++i) { const int ch = tid + 512 * i; \
                { const int s = ch >> 4, c16 = ch & 15; pk[i] = *(const u32x4*)(QK + (size_t)(b * 2048 + 64 * (kbb) + s) * 4096 + 2048 + hh * 128 + c16 * 8); } \
                { const int grp = ch >> 9, d = (ch >> 2) & 127, c4 = ch & 3; pv[i] = *(const u32x4*)(V1 + ((size_t)(((b * 2048 + 64 * (kbb)) >> 5) + grp) * 2048 + 1024 + hh * 128 + d) * 32 + c4 * 8); } } } while (0)
#define SB_STORE(bufo) do { _Pragma("unroll") for (int i = 0; i < 2; ++i) { const int ch = tid + 512 * i; \
                { const int s = ch >> 4, c16 = ch & 15; *(LAS u32x4*)(sK + (bufo) + s * 136 + c16 * 8) = pk[i]; } \
                { const int grp = ch >> 9, d = (ch >> 2) & 127, c4 = ch & 3; *(LAS u32x4*)(sV + (bufo) + (grp * 128 + d) * 32 + c4 * 8) = pv[i]; } } } while (0)
            __syncthreads();
            SB_STORE(0);
            SB_LOAD(2 * qb);
            int cur = 0;
            for (int kb = 2 * qb + 1; kb >= 0; --kb) {
                const bool wdone = (__ballot(R >= -160.0f) == 0ull);
                if (lane == 0) sDone[(it & 1) * 8 + w] = wdone ? 0 : 1;
                __syncthreads();
                { const LAS int* dn = sDone + (it & 1) * 8; const int any = dn[0] | dn[1] | dn[2] | dn[3] | dn[4] | dn[5] | dn[6] | dn[7]; ++it; if (!any) break; }
                const int bo = cur * SB_BUF;
                if (kb > 0) { SB_STORE((cur ^ 1) * SB_BUF); if (kb > 1) SB_LOAD(kb - 2); }
                cur ^= 1;
                if (wdone || 64 * kb >= 128 * qb + 16 * w + 15) continue;
                f32x4 zt[4];
#pragma unroll
                for (int st = 0; st < 4; ++st) zt[st] = (f32x4){0.f, 0.f, 0.f, 0.f};
#pragma unroll
                for (int kh = 0; kh < 2; ++kh) {
                    bf16x8 kf[4][2];
#pragma unroll
                    for (int st = 0; st < 4; ++st)
#pragma unroll
                        for (int k2 = 0; k2 < 2; ++k2) kf[st][k2] = *(const LAS bf16x8*)(sK + bo + (16 * st + fr) * 136 + 32 * (2 * kh + k2) + 8 * fq);
                    __builtin_amdgcn_sched_barrier(0);
#pragma unroll
                    for (int k2 = 0; k2 < 2; ++k2)
#pragma unroll
                        for (int st = 0; st < 4; ++st) zt[st] = MFMA16(kf[st][k2], qf[2 * kh + k2], zt[st]);
                    __builtin_amdgcn_sched_barrier(0); }
                float lb[4][4], l1[4][4], P[4], sfx[4], TT[4];
#pragma unroll
                for (int st = 0; st < 4; ++st) { P[st] = 0.f;
#pragma unroll
                    for (int r = 0; r < 4; ++r) { const float zz = zt[st][r] * scale; const float lbv = logsig2_f(zz);
                        const bool strict = (64 * kb + 16 * st + 4 * fq + r) < tq;
                        lb[st][r] = strict ? lbv : -1.0e30f; l1[st][r] = strict ? (lbv - zz) : 0.f; P[st] += l1[st][r]; } }
#pragma unroll
                for (int st = 0; st < 4; ++st) { const float x16 = __shfl_xor(P[st], 16), x32 = __shfl_xor(P[st], 32), x48 = __shfl_xor(x16, 32);
                    TT[st] = P[st] + x16 + x32 + x48;
                    sfx[st] = fq == 0 ? (x16 + x32 + x48) : fq == 1 ? (x32 + x48) : fq == 2 ? x16 : 0.f; }
                float run = R;
#pragma unroll
                for (int st = 3; st >= 0; --st) { float a = run + sfx[st];
#pragma unroll
                    for (int r = 3; r >= 0; --r) { zt[st][r] = __builtin_amdgcn_exp2f(lb[st][r] + a); a += l1[st][r]; }
                    run += TT[st]; }
                R = run;
                const bf16x8 wf0 = pack8(zt[0], zt[1]), wf1 = pack8(zt[2], zt[3]);
#pragma unroll
                for (int dh = 0; dh < 2; ++dh) {
                    bf16x8 vf0[4], vf1[4];
#pragma unroll
                    for (int d4 = 0; d4 < 4; ++d4) { vf0[d4] = *(const LAS bf16x8*)(sV + bo + (16 * (4 * dh + d4) + fr) * 32 + fq * 8); vf1[d4] = *(const LAS bf16x8*)(sV + bo + (128 + 16 * (4 * dh + d4) + fr) * 32 + fq * 8); }
                    __builtin_amdgcn_sched_barrier(0);
#pragma unroll
                    for (int d4 = 0; d4 < 4; ++d4) oacc[4 * dh + d4] = MFMA16(vf0[d4], wf0, oacc[4 * dh + d4]);
#pragma unroll
                    for (int d4 = 0; d4 < 4; ++d4) oacc[4 * dh + d4] = MFMA16(vf1[d4], wf1, oacc[4 * dh + d4]);
                    __builtin_amdgcn_sched_barrier(0); }
            }
#pragma unroll
            for (int d = 0; d < 8; ++d) { u32x2 ow; ow.x = cvt_pk_bf16(oacc[d][0], oacc[d][1]); ow.y = cvt_pk_bf16(oacc[d][2], oacc[d][3]);
                *(u32x2*)(QK + qrow + 16 * d + 4 * fq) = ow; }
        }
    }
#undef SB_LOAD
#undef SB_STORE
#undef SB_NEXT
#undef SB_QB
    __syncthreads();
}

__device__ void phase_final(int wv, float* out, const float* g) {
    const int tid = opaque_tid(wv), lane = tid & 63, wave = tid >> 6;
    f32x4 gf[4];
#pragma unroll
    for (int i = 0; i < 4; ++i) gf[i] = *(const f32x4*)(g + i * 256 + lane * 4);
    for (int r0 = (blockIdx.x * 8 + wave) * 4; r0 < M; r0 += gridDim.x * 32) {
        f32x4 xr[4][4];
#pragma unroll
        for (int u = 0; u < 4; ++u)
#pragma unroll
            for (int i = 0; i < 4; ++i) xr[u][i] = *(const f32x4*)(out + (size_t)(r0 + u) * D + i * 256 + lane * 4);
        __builtin_amdgcn_sched_barrier(0);
#pragma unroll
        for (int u = 0; u < 4; ++u) { float ssq = 0.f;
#pragma unroll
            for (int i = 0; i < 4; ++i) ssq += xr[u][i][0] * xr[u][i][0] + xr[u][i][1] * xr[u][i][1] + xr[u][i][2] * xr[u][i][2] + xr[u][i][3] * xr[u][i][3];
            ssq = wave_sum(ssq);
            const float rstd = __builtin_amdgcn_rsqf(ssq * (1.0f / 1024.0f) + EPS);
#pragma unroll
            for (int i = 0; i < 4; ++i) *(f32x4*)(out + (size_t)(r0 + u) * D + i * 256 + lane * 4) = xr[u][i] * rstd * gf[i]; }
    }
}

#define XB_TMO      128
#define XB_XCNT(j)  (256  + 64 * (j))
#define XB_XSUB(j)  (1280 + 64 * (j))
#define XB_XGEN(j)  (2304 + 64 * (j))
#define XB_TOP      3328
#define XB_TOPGEN   3392
#define XCD_BAR_WORDS 3456
#define XB_SPIN_CAP (1u << 18)
__device__ __forceinline__ unsigned xb_ld(unsigned* p)              { return __hip_atomic_load(p, __ATOMIC_RELAXED, __HIP_MEMORY_SCOPE_AGENT); }
__device__ __forceinline__ unsigned xb_add(unsigned* p, unsigned v) { return __hip_atomic_fetch_add(p, v, __ATOMIC_RELAXED, __HIP_MEMORY_SCOPE_AGENT); }
__device__ __forceinline__ unsigned xb_xcc_id() { return (unsigned)__builtin_amdgcn_s_getreg((3 << 11) | 20) & 0xFu; }
#define XB_SPIN(cond, bar) do { unsigned _sp = 0; while (cond) { __builtin_amdgcn_s_sleep(1); \
    if ((++_sp & 255u) == 0u) { if (xb_ld(&(bar)[XB_TMO])) break; if (_sp > XB_SPIN_CAP) { atomicAdd(&(bar)[XB_TMO], 1u); break; } } } } while (0)
struct XcdBarrier { unsigned* bar; unsigned x; volatile LAS unsigned* st; };
__device__ __forceinline__ void xcd_barrier_complete(unsigned* bar, unsigned x, unsigned& nloc, unsigned& nx) {
    const unsigned G = gridDim.x * gridDim.y * gridDim.z;
    unsigned sum, cnt, mine, sp = 0u;
    for (;;) {
        sum = 0u; cnt = 0u; mine = 0u;
#pragma unroll
        for (unsigned j = 0; j < 16; ++j) { const unsigned c = xb_ld(&bar[XB_XCNT(j)]); sum += c; cnt += (c > 0u) ? 1u : 0u; mine = (j == x) ? c : mine; }
        if (sum == G) break;
        __builtin_amdgcn_s_sleep(1);
        if ((++sp & 255u) == 0u) { if (xb_ld(&bar[XB_TMO])) break; if (sp > XB_SPIN_CAP) { atomicAdd(&bar[XB_TMO], 1u); break; } }
    }
    nloc = mine > 0u ? mine : 1u; nx = cnt > 0u ? cnt : 1u;
}
__device__ __forceinline__ void xcd_barrier(const XcdBarrier& b, bool leader_thread) {
    asm volatile("s_waitcnt vmcnt(0)" ::: "memory");
    __syncthreads();
    if (leader_thread) {
        unsigned* bar = b.bar;
        __builtin_amdgcn_s_waitcnt(0);
        unsigned nloc = b.st[0], nx = b.st[1];
        if (nloc == 0u) { xcd_barrier_complete(bar, b.x, nloc, nx); b.st[0] = nloc; b.st[1] = nx; }
        const unsigned old = xb_add(&bar[XB_XSUB(b.x)], 1u);
        const unsigned gen = old / nloc;
        if (old + 1u == (gen + 1u) * nloc) {
            __builtin_amdgcn_fence(__ATOMIC_RELEASE, "agent");
            asm volatile("s_waitcnt vmcnt(0)" ::: "memory");
            const unsigned og = xb_add(&bar[XB_TOP], 1u);
            const unsigned tg = og / nx;
            if (og + 1u == (tg + 1u) * nx) xb_add(&bar[XB_TOPGEN], 1u);
            else XB_SPIN(xb_ld(&bar[XB_TOPGEN]) == tg, bar);
            __builtin_amdgcn_fence(__ATOMIC_ACQUIRE, "agent");
            xb_add(&bar[XB_XGEN(b.x)], 1u);
            asm volatile("s_waitcnt vmcnt(0)" ::: "memory");
        } else {
            XB_SPIN(xb_ld(&bar[XB_XGEN(b.x)]) == gen, bar);
            __builtin_amdgcn_fence(__ATOMIC_ACQUIRE, "agent");
            asm volatile("s_waitcnt vmcnt(0)" ::: "memory");
        }
    }
    __syncthreads();
}

__global__ void __launch_bounds__(512, 2) mega_fwd(Args a) {
    extern __shared__ __attribute__((aligned(16))) unsigned char shm[];
    cg::grid_group grid = cg::this_grid();
    LAS unsigned char* lds = (LAS unsigned char*)shm;
    unsigned char* ws = a.ws;
    bf16_t* IN0T = (bf16_t*)(ws + WS_IN0T); bf16_t* OUT0T = (bf16_t*)(ws + WS_OUT0T); bf16_t* IN1T = (bf16_t*)(ws + WS_IN1T); bf16_t* OUT1T = (bf16_t*)(ws + WS_OUT1T);
    bf16_t* POOLT = (bf16_t*)(ws + WS_POOLT); float* SGUW = (float*)(ws + WS_SGUW); float* ADA = (float*)(ws + WS_ADA); float* GLR = (float*)(ws + WS_GLR); float* SSQ = (float*)(ws + WS_SSQ);
    bf16_t* H = (bf16_t*)(ws + WS_H); bf16_t* AU = (bf16_t*)(ws + WS_BUFA); bf16_t* Y0 = AU + (size_t)M * 2048; bf16_t* QK = AU;
    bf16_t* V0 = (bf16_t*)(ws + WS_BUFV); bf16_t* P = V0 + (size_t)M * 1024; bf16_t* V1 = V0;
    const int G = gridDim.x, c = blockIdx.x;
    const int wv = __builtin_amdgcn_readfirstlane(threadIdx.x >> 6);
    volatile LAS unsigned* xbst = (volatile LAS unsigned*)(lds + 131072);
    if (threadIdx.x == 0) { xbst[0] = 0u; xbst[1] = 0u; }
    __syncthreads();
    XcdBarrier xbar; xbar.bar = (unsigned*)(ws + WS_BAR); xbar.x = xb_xcc_id(); xbar.st = xbst;
    if (a.ph_hi - a.ph_lo > 1 && threadIdx.x == 0) (void)xb_add(&xbar.bar[XB_XCNT(xbar.x)], 1u);
    if (a.ph_lo < 0) grid.sync();
    for (int ph = a.ph_lo; ph < a.ph_hi; ++ph) {
        switch (ph) {
        case 0: phase_prep(wv, a, (LAS float*)lds); break;
        case 1: phase_h(wv, a.in[I_X], a.in[I_NORMG], ADA, H, false, nullptr, nullptr, (LAS float*)lds); break;
        case 2: {
            { pg8::Gemm g{H, H, IN0T}; pg8::StaticOrder S; S.init(M, 2048, G, c); pg8::EpiRow<0> E{AU, 2048, nullptr, nullptr};
              pg8::gemm_phase<pg8::EpiRow<0>, pg8::StaticOrder, true, 1024, 1024, 16>(wv, lds, g, S, E); }
            { pg8::Gemm g{H, H, IN0T + (size_t)2048 * 1024}; pg8::StaticOrder S; S.init(M, 1024, G, c); pg8::EpiVBlk E{V0, 1024};
              pg8::gemm_phase<pg8::EpiVBlk, pg8::StaticOrder, false, 1024, 1024, 16>(wv, lds, g, S, E); }
            { pg8::Gemm g{H, H, IN0T + (size_t)3072 * 1024}; pg8::StaticOrder S; S.init(M, 2048, G, c); pg8::EpiRow<1> E{Y0, 2048, nullptr, nullptr};
              pg8::gemm_phase<pg8::EpiRow<1>, pg8::StaticOrder, true, 1024, 1024, 16>(wv, lds, g, S, E); }
        } break;
        case 3: phase_poolp(wv, AU, P); phase_sgu(wv, AU, V0, Y0, SGUW, a.in[I_SGUB], a.in[I_SGUG], (LAS float*)lds); break;
        case 4: { pg8::Gemm g{P, P, POOLT}; pg8::PoolOrder S{G, c}; pg8::EpiRow<2> E{Y0, 2048, nullptr, nullptr};
              pg8::gemm_phase<pg8::EpiRow<2>, pg8::PoolOrder, true, 256, 1024, 4>(wv, lds, g, S, E); } break;
        case 5: { pg8::Gemm g{Y0, Y0, OUT0T}; pg8::StaticOrder S; S.init(M, 1024, G, c); pg8::EpiOut E{a.in[I_X], a.out, ADA + 2048};
              pg8::gemm_phase<pg8::EpiOut, pg8::StaticOrder, true, 2048, 2048, 32>(wv, lds, g, S, E); } break;
        case 6: phase_h(wv, a.out, a.in[I_NORMG] + 1024, ADA + 16 * 3072, H, true, a.in[I_OINW], GLR, (LAS float*)lds); break;
        case 7: {
            { pg8::Gemm g{H, H, IN1T}; pg8::StaticOrder S; S.init(M, 3072, G, c); pg8::EpiRow<0> E{QK, 4096, nullptr, nullptr};
              pg8::gemm_phase<pg8::EpiRow<0>, pg8::StaticOrder, true, 1024, 1024, 16>(wv, lds, g, S, E); }
            { pg8::Gemm g{H, H, IN1T + (size_t)3072 * 1024}; pg8::StaticOrder S; S.init(M, 2048, G, c); pg8::EpiVBlk E{V1, 2048};
              pg8::gemm_phase<pg8::EpiVBlk, pg8::StaticOrder, false, 1024, 1024, 16>(wv, lds, g, S, E); }
        } break;
        case 8: phase_glapre(wv, QK, GLR, (float*)(ws + WS_EB), a.in[I_GGW], a.in[I_GGB], lds); phase_sb(wv, QK, V1, lds); break;
        case 9: phase_gla2(wv, QK, V1, QK + 3072, (const float*)(ws + WS_EB), SSQ, lds); break;
        case 10: { pg8::Gemm g{H, H, IN1T + (size_t)5120 * 1024}; pg8::StaticOrder S; S.init(M, 2048, G, c); pg8::EpiRow<3> E{QK, 4096, SSQ, a.in[I_GNG]};
              pg8::gemm_phase<pg8::EpiRow<3>, pg8::StaticOrder, true, 1024, 1024, 16>(wv, lds, g, S, E); } break;
        case 11: { pg8::Gemm g{QK + 3072, QK + 1024, OUT1T}; pg8::StaticOrder S; S.init(M, 1024, G, c); pg8::EpiOut E{a.out, a.out, ADA + 16 * 3072 + 2048};
              pg8::gemm_phase<pg8::EpiOut, pg8::StaticOrder, true, 2048, 4096, 16>(wv, lds, g, S, E); } break;
        case 12: phase_final(wv, a.out, a.in[I_FG]); break;
        }
        if (ph + 1 < a.ph_hi) xcd_barrier(xbar, opaque_tid(wv) == 0);
    }
}

extern "C" void kernel_launch(void* const* d_in, const int* in_sizes, int n_in, void* d_out, int out_size, void* d_ws, size_t ws_size, hipStream_t stream) {
    static int grid = 0;
    if (grid == 0) {
        if (n_in != 18 || out_size != M * D || ws_size < WS_END) { fprintf(stderr, "kernel_launch: unexpected shapes (n_in %d out %d ws %zu need %zu)\n", n_in, out_size, ws_size, (size_t)WS_END); grid = -1; return; }
        int dev = 0, cus = 0, per_cu = 0;
        hipGetDevice(&dev); hipDeviceGetAttribute(&cus, hipDeviceAttributeMultiprocessorCount, dev);
        if (hipFuncSetAttribute((const void*)mega_fwd, hipFuncAttributeMaxDynamicSharedMemorySize, LDS_BYTES) != hipSuccess) { fprintf(stderr, "kernel_launch: hipFuncSetAttribute failed\n"); grid = -1; return; }
        if (hipOccupancyMaxActiveBlocksPerMultiprocessor(&per_cu, (const void*)mega_fwd, 512, LDS_BYTES) != hipSuccess || per_cu < 1) { fprintf(stderr, "kernel_launch: occupancy query says %d blocks/CU\n", per_cu); per_cu = 1; }
        (void)hipGetLastError();
        grid = cus;
    }
    if (grid < 0) return;
    Args a{};
    for (int i = 0; i < 18; ++i) a.in[i] = (const float*)d_in[i];
    a.out = (float*)d_out; a.ws = (unsigned char*)d_ws;
#if N_LAUNCH_MODE == 1
    a.ph_lo = 0; a.ph_hi = NPHASE;
    (void)hipMemsetAsync((unsigned char*)d_ws + WS_BAR, 0, 16384, stream);
    void* args[] = {&a};
    hipError_t e = hipLaunchCooperativeKernel((const void*)mega_fwd, dim3(grid), dim3(512), args, LDS_BYTES, stream);
    if (e != hipSuccess) fprintf(stderr, "cooperative launch failed: %s (grid %d)\n", hipGetErrorString(e), grid);
#else
    for (int ph = 0; ph < NPHASE; ++ph) { a.ph_lo = ph; a.ph_hi = ph + 1; hipLaunchKernelGGL(mega_fwd, dim3(grid), dim3(512), LDS_BYTES, stream, a); }
#endif
}
```

```cpp
#include <hip/hip_runtime.h>
#include <hip/hip_cooperative_groups.h>
#include <cstdio>
namespace cg = cooperative_groups;

#ifndef N_LAUNCH_MODE
#define N_LAUNCH_MODE 1
#endif

#define LAS __attribute__((address_space(3)))
typedef unsigned short bf16_t;
typedef short bf16x8 __attribute__((ext_vector_type(8)));
typedef float f32x4 __attribute__((ext_vector_type(4)));
typedef unsigned u32x4 __attribute__((ext_vector_type(4)));
typedef unsigned u32x2 __attribute__((ext_vector_type(2)));

constexpr int NB = 16, SEQ = 2048, D = 1024, M = NB * SEQ;
constexpr float EPS = 1e-6f;
constexpr int LDS_BYTES = 131072 + 16;
constexpr int NPHASE = 13;

constexpr size_t WS_BAR = 0;
constexpr size_t WS_IN0T = 16384;
constexpr size_t WS_OUT0T = WS_IN0T + 5120ull * 1024 * 2;
constexpr size_t WS_IN1T = WS_OUT0T + 1024ull * 2048 * 2;
constexpr size_t WS_OUT1T = WS_IN1T + 7168ull * 1024 * 2;
constexpr size_t WS_POOLT = WS_OUT1T + 1024ull * 2048 * 2;
constexpr size_t WS_SGUW = WS_POOLT + 1024ull * 256 * 2;
constexpr size_t WS_ADA = WS_SGUW + 8ull * 128 * 128 * 4;
constexpr size_t WS_GLR = WS_ADA + 2ull * 16 * 3072 * 4;
constexpr size_t WS_SSQ = WS_GLR + (size_t)M * 16 * 4;
constexpr size_t WS_H = WS_SSQ + (size_t)M * 32 * 4;
constexpr size_t WS_BUFA = WS_H + (size_t)M * 1024 * 2;
constexpr size_t WS_BUFV = WS_BUFA + (size_t)M * 4096 * 2;
constexpr size_t WS_EB = WS_BUFV + (size_t)M * 2048 * 2;
constexpr size_t WS_END = WS_EB + 2048ull * 128 * 4;

typedef float f32x2 __attribute__((ext_vector_type(2)));
typedef __bf16 bf16x2_t __attribute__((ext_vector_type(2)));
__device__ __forceinline__ unsigned cvt_pk_bf16(float lo, float hi) { const f32x2 v = {lo, hi}; return __builtin_bit_cast(unsigned, __builtin_convertvector(v, bf16x2_t)); }
__device__ __forceinline__ unsigned cvt_pk_bf16_asm(float lo, float hi) { unsigned r; asm("v_cvt_pk_bf16_f32 %0, %1, %2" : "=v"(r) : "v"(lo), "v"(hi)); return r; }
__device__ __forceinline__ float bf2f(bf16_t b) { return __uint_as_float(((unsigned)b) << 16); }
__device__ __forceinline__ float bflo(unsigned u) { return __uint_as_float(u << 16); }
__device__ __forceinline__ float bfhi(unsigned u) { return __uint_as_float(u & 0xffff0000u); }
__device__ __forceinline__ bf16_t f2bf(float f) { return (bf16_t)(cvt_pk_bf16(f, 0.f) & 0xffffu); }
__device__ __forceinline__ float silu_f(float x) { return x * __builtin_amdgcn_rcpf(1.0f + __builtin_amdgcn_exp2f(-1.4426950408889634f * x)); }
__device__ __forceinline__ float logsig2_f(float z2) { return fminf(z2, 0.f) - __builtin_amdgcn_logf(1.0f + __builtin_amdgcn_exp2f(-fabsf(z2))); }
__device__ __forceinline__ int vslot(int x) { return ((x >> 2) & 3) * 8 + ((x >> 4) & 1) * 4 + (x & 3); }
__device__ __forceinline__ float wave_sum(float v) {
#pragma unroll
    for (int m = 32; m >= 1; m >>= 1) v += __shfl_xor(v, m);
    return v;
}
__device__ __forceinline__ bf16x8 pack8(f32x4 a, f32x4 b) {
    u32x4 w; w.x = cvt_pk_bf16(a[0], a[1]); w.y = cvt_pk_bf16(a[2], a[3]); w.z = cvt_pk_bf16(b[0], b[1]); w.w = cvt_pk_bf16(b[2], b[3]);
    return __builtin_bit_cast(bf16x8, w);
}
__device__ __forceinline__ int opaque_tid(int wv) { int t = (wv << 6) | (int)__builtin_amdgcn_mbcnt_hi(~0u, __builtin_amdgcn_mbcnt_lo(~0u, 0u)); asm volatile("" : "+v"(t)); return t; }
#define MFMA16(a, b, c) __builtin_amdgcn_mfma_f32_16x16x32_bf16((a), (b), (c), 0, 0, 0)

namespace pg8 {
constexpr int BM = 256, BK = 64, HALF = 128, HTB = HALF * BK * 2, STAGE_BYTES = 8 * HTB, NXCD = 8, WGM = 8;
__host__ __device__ __forceinline__ int lds_byte(int r, int c) { const int st = (r >> 4) * 2 + (c >> 5), rr = r & 15, cc = c & 31, ob = rr * 64 + cc * 2; return st * 1024 + (ob ^ (((ob >> 9) & 1) << 5)); }
__host__ __device__ __forceinline__ void stage_rc(int b, int& R, int& C) { const int st = b / 1024, sb = b % 1024, swz = sb ^ (((sb >> 9) & 1) << 5); R = (st >> 1) * 16 + swz / 64; C = (st & 1) * 32 + (swz % 64) / 2; }
__host__ __device__ __forceinline__ int perm32(int rho) { const int n = rho >> 4, i = rho & 15; return 8 * (i >> 2) + 4 * n + (i & 3); }

struct Unit { int pm, pn; unsigned aoff; };
struct Gemm { const bf16_t* A; const bf16_t* A1; const bf16_t* Bt; };

struct StaticOrder {
    int nM, nN, nwg, G, c;
    __device__ void init(int M_, int N_, int G_, int c_) { nM = M_ / BM; nN = N_ / BM; nwg = nM * nN; G = G_; c = c_; }
    __device__ bool next(int i, Unit& u) const {
        const long L = (long)i * G + c; if (L >= nwg) return false;
        int wgid = (int)L; { const int q = nwg / NXCD, r = nwg % NXCD, xcd = wgid % NXCD, off = wgid / NXCD; wgid = (xcd < r ? xcd * (q + 1) : r * (q + 1) + (xcd - r) * q) + off; }
        const int nig = WGM * nN, gid = wgid / nig, fm = gid * WGM, gsz = (nM - fm) < WGM ? (nM - fm) : WGM;
        u.pm = fm + ((wgid % nig) % gsz); u.pn = (wgid % nig) / gsz; u.aoff = 0; return true;
    }
};
struct PoolOrder {
    int G, c;
    __device__ bool next(int i, Unit& u) const {
        const int L = i * G + c; if (L >= 512) return false;
        u.pm = L >> 2; u.pn = L & 3; u.aoff = (unsigned)(u.pn * 256 * 2); return true;
    }
};

template <class Epi, class Sched, bool SWAP, int K, int lda, int ksplit>
__device__ __forceinline__ void gemm_phase(int wv, LAS unsigned char* lds, const Gemm g, const Sched& S, const Epi& E) {
    const int tid = opaque_tid(wv), wid = __builtin_amdgcn_readfirstlane(tid >> 6), lane = tid & 63, wr = wid >> 2, wc = wid & 3, fr = lane & 15, fq = lane >> 4;
    constexpr int nt = K / BK;
    unsigned voffA[2], voffB[2];
#pragma unroll
    for (int i = 0; i < 2; ++i) { int R, C; stage_rc(tid * 16 + i * 8192, R, C); const int Rb = Epi::PERM ? ((R & ~31) + perm32(R & 31)) : R;
        voffA[i] = (unsigned)(R * lda + C) * 2u; voffB[i] = (unsigned)(Rb * K + C) * 2u; }
    const size_t kstep = (size_t)(BK * 2);
    const size_t hstepA = (size_t)HALF * lda * 2, hstepB = (size_t)HALF * K * 2;
    const size_t tstepA = 2 * hstepA, tstepB = 2 * hstepB;
    const unsigned ldsw = (unsigned)wid * 1024u;
    const int aoff = lds_byte(wr * 64 + fr, fq * 8), boff = lds_byte(wc * 32 + fr, fq * 8);
#define PG8_SA(b, h) (((b) * 2 + (h)) * HTB)
#define PG8_SB(b, h) ((4 + (b) * 2 + (h)) * HTB)
#define PG8_STAGE(bufoff, gbase, voff) do { _Pragma("unroll") for (int _i = 0; _i < 2; ++_i) \
        __builtin_amdgcn_global_load_lds((const unsigned*)((const char*)(gbase) + (voff)[_i]), (LAS unsigned*)(lds + (bufoff) + ldsw + _i * 8192), 16, 0, 0); } while (0)
#define PG8_LDA(dst, b, h) do { _Pragma("unroll") for (int m = 0; m < 4; ++m) _Pragma("unroll") for (int k = 0; k < 2; ++k) dst[m][k] = *(const LAS bf16x8*)(lds + PG8_SA(b, h) + aoff + m * 2048 + k * 1024); } while (0)
#define PG8_LDB(dst, b, h) do { _Pragma("unroll") for (int n = 0; n < 2; ++n) _Pragma("unroll") for (int k = 0; k < 2; ++k) dst[n][k] = *(const LAS bf16x8*)(lds + PG8_SB(b, h) + boff + n * 2048 + k * 1024); } while (0)
#define PG8_MMA(ai, bj, At, Bt) do { __builtin_amdgcn_s_setprio(1); _Pragma("unroll") for (int m = 0; m < 4; ++m) _Pragma("unroll") for (int n = 0; n < 2; ++n) _Pragma("unroll") for (int k = 0; k < 2; ++k) \
        acc[ai][bj][m][n] = SWAP ? __builtin_amdgcn_mfma_f32_16x16x32_bf16(Bt[n][k], At[m][k], acc[ai][bj][m][n], 0, 0, 0) \
                                 : __builtin_amdgcn_mfma_f32_16x16x32_bf16(At[m][k], Bt[n][k], acc[ai][bj][m][n], 0, 0, 0); __builtin_amdgcn_s_setprio(0); } while (0)
#define PG8_WAIT_V(n) asm volatile("s_waitcnt vmcnt(" #n ")" ::: "memory")
#define PG8_WAIT_L(n) asm volatile("s_waitcnt lgkmcnt(" #n ")" ::: "memory")
#define PG8_BAR __builtin_amdgcn_s_barrier()
#define PG8_SCHED __builtin_amdgcn_sched_barrier(0)
#define PG8_APTR(p0, p1, tt) ((ksplit >= nt || (tt) < ksplit) ? (p0) + (size_t)(tt) * kstep : (p1) + (size_t)((tt) - ksplit) * kstep)
    Unit cur, nxt; int ui = 0;
    if (!S.next(0, cur)) return;
    f32x4 acc[2][2][4][2];
#pragma unroll
    for (int a = 0; a < 2; ++a)
#pragma unroll
        for (int b = 0; b < 2; ++b)
#pragma unroll
            for (int m = 0; m < 4; ++m)
#pragma unroll
                for (int n = 0; n < 2; ++n) acc[a][b][m][n] = (f32x4){0.f, 0.f, 0.f, 0.f};
    bf16x8 At[4][2], B0[2][2], B1[2][2];
    const char* cA = (const char*)g.A + (size_t)cur.pm * tstepA + cur.aoff; const char* cA1 = (const char*)g.A1 + (size_t)cur.pm * tstepA;
    const char* cB = (const char*)g.Bt + (size_t)cur.pn * tstepB;
    PG8_STAGE(PG8_SB(0, 0), cB, voffB); PG8_STAGE(PG8_SB(0, 1), cB + hstepB, voffB); PG8_STAGE(PG8_SA(0, 0), cA, voffA); PG8_STAGE(PG8_SA(0, 1), cA + hstepA, voffA);
    if (wr == 1) PG8_BAR;
    PG8_WAIT_V(2); PG8_BAR;
    PG8_STAGE(PG8_SB(1, 0), cB + kstep, voffB); PG8_STAGE(PG8_SA(1, 0), cA + kstep, voffA); PG8_STAGE(PG8_SB(1, 1), cB + hstepB + kstep, voffB);
    PG8_WAIT_V(6); PG8_BAR;
    for (;;) {
        const bool has_next = S.next(ui + 1, nxt);
        const char* nA = has_next ? (const char*)g.A + (size_t)nxt.pm * tstepA + nxt.aoff : cA; const char* nA1 = has_next ? (const char*)g.A1 + (size_t)nxt.pm * tstepA : cA1;
        const char* nB = has_next ? (const char*)g.Bt + (size_t)nxt.pn * tstepB : cB;
#pragma unroll 1
        for (int t = 0; t < nt; t += 2) {
            const bool last = (t == nt - 2);
            const char* a1 = PG8_APTR(cA, cA1, t + 1);
            const char* a2 = last ? nA : PG8_APTR(cA, cA1, t + 2); const char* b2 = last ? nB : cB + (size_t)(t + 2) * kstep;
            const char* a3 = last ? nA + kstep : PG8_APTR(cA, cA1, t + 3); const char* b3 = b2 + kstep;
            PG8_LDB(B0, 0, 0); PG8_LDB(B1, 0, 1); PG8_SCHED; PG8_LDA(At, 0, 0); PG8_STAGE(PG8_SA(1, 1), a1 + hstepA, voffA);
            PG8_WAIT_V(8); PG8_WAIT_L(0); PG8_BAR; PG8_MMA(0, 0, At, B0); PG8_MMA(0, 1, At, B1); PG8_BAR; PG8_SCHED;
            PG8_LDA(At, 0, 1); PG8_STAGE(PG8_SB(0, 0), b2, voffB); PG8_STAGE(PG8_SB(0, 1), b2 + hstepB, voffB); PG8_STAGE(PG8_SA(0, 0), a2, voffA);
            PG8_WAIT_V(8); PG8_WAIT_L(0); PG8_BAR; PG8_MMA(1, 0, At, B0); PG8_MMA(1, 1, At, B1); PG8_BAR; PG8_SCHED;
            PG8_LDB(B0, 1, 0); PG8_LDB(B1, 1, 1); PG8_SCHED; PG8_LDA(At, 1, 0); PG8_STAGE(PG8_SA(0, 1), a2 + hstepA, voffA);
            PG8_WAIT_V(8); PG8_WAIT_L(0); PG8_BAR; PG8_MMA(0, 0, At, B0); PG8_MMA(0, 1, At, B1); PG8_BAR; PG8_SCHED;
            PG8_LDA(At, 1, 1); PG8_STAGE(PG8_SB(1, 0), b3, voffB); PG8_STAGE(PG8_SB(1, 1), b3 + hstepB, voffB); PG8_STAGE(PG8_SA(1, 0), a3, voffA);
            PG8_WAIT_V(8); PG8_WAIT_L(0); PG8_BAR; PG8_MMA(1, 0, At, B0); PG8_MMA(1, 1, At, B1); PG8_BAR; PG8_SCHED;
        }
        if (wr == 0) PG8_BAR;
        E(acc, cur, wr, wc, fr, fq);
        if (!has_next) break;
#pragma unroll
        for (int a = 0; a < 2; ++a)
#pragma unroll
            for (int b = 0; b < 2; ++b)
#pragma unroll
                for (int m = 0; m < 4; ++m)
#pragma unroll
                    for (int n = 0; n < 2; ++n) acc[a][b][m][n] = (f32x4){0.f, 0.f, 0.f, 0.f};
        cur = nxt; cA = nA; cA1 = nA1; cB = nB; ++ui;
        if (wr == 1) PG8_BAR;
    }
    PG8_WAIT_V(0);
    PG8_BAR;
#undef PG8_SA
#undef PG8_SB
#undef PG8_STAGE
#undef PG8_LDA
#undef PG8_LDB
#undef PG8_MMA
#undef PG8_WAIT_V
#undef PG8_WAIT_L
#undef PG8_BAR
#undef PG8_SCHED
#undef PG8_APTR
}

template <int MODE> struct EpiRow {
    static constexpr bool PERM = true;
    bf16_t* O; int ldc; const float* ssq; const float* gn;
    __device__ __forceinline__ void operator()(const f32x4 (&acc)[2][2][4][2], const Unit& u, int wr, int wc, int fr, int fq) const {
        const int row0 = u.pm * BM + wr * 64 + fr; const int colt = u.pn * BM;
        int dcol = colt;
        if (MODE == 3) dcol = (colt < 1024) ? 3072 + colt : colt;
        const bool ycpart = (MODE == 3) && (colt < 1024);
        f32x4 gg[2][2];
        if (MODE == 3) {
#pragma unroll
            for (int bj = 0; bj < 2; ++bj) { const int cy = (ycpart ? colt : 0) + bj * HALF + wc * 32 + 8 * fq; gg[bj][0] = *(const f32x4*)(gn + cy); gg[bj][1] = *(const f32x4*)(gn + cy + 4); } }
#pragma unroll
        for (int ai = 0; ai < 2; ++ai)
#pragma unroll
            for (int mh = 0; mh < 2; ++mh) {
                u32x4 old[2][2]; f32x4 sq[2][2];
                if (MODE == 2 || MODE == 3) {
#pragma unroll
                    for (int m2 = 0; m2 < 2; ++m2) { const int row = row0 + ai * HALF + (2 * mh + m2) * 16;
#pragma unroll
                        for (int bj = 0; bj < 2; ++bj) old[m2][bj] = *(const u32x4*)(O + (size_t)row * ldc + dcol + bj * HALF + wc * 32 + 8 * fq);
                        if (MODE == 3) { const int head = ycpart ? (colt >> 8) : 0;
                            sq[m2][0] = *(const f32x4*)(ssq + ((size_t)row * 4 + head) * 8); sq[m2][1] = *(const f32x4*)(ssq + ((size_t)row * 4 + head) * 8 + 4); } }
                    __builtin_amdgcn_sched_barrier(0); }
#pragma unroll
                for (int m2 = 0; m2 < 2; ++m2) { const int m = 2 * mh + m2; const int row = row0 + ai * HALF + m * 16;
                    float rstd = 1.0f;
                    if (MODE == 3) rstd = __builtin_amdgcn_rsqf((sq[m2][0][0] + sq[m2][0][1] + sq[m2][0][2] + sq[m2][0][3] + sq[m2][1][0] + sq[m2][1][1] + sq[m2][1][2] + sq[m2][1][3]) * (1.0f / 256.0f) + EPS);
#pragma unroll
                    for (int bj = 0; bj < 2; ++bj) {
                        const int cin = bj * HALF + wc * 32 + 8 * fq;
                        bf16_t* p = O + (size_t)row * ldc + dcol + cin;
                        f32x4 v0 = acc[ai][bj][m][0], v1 = acc[ai][bj][m][1];
                        if (MODE == 1) {
#pragma unroll
                            for (int j = 0; j < 4; ++j) { v0[j] = silu_f(v0[j]); v1[j] = silu_f(v1[j]); } }
                        if (MODE == 2) { const u32x4 o = old[m2][bj];
                            v0[0] *= bflo(o.x); v0[1] *= bfhi(o.x); v0[2] *= bflo(o.y); v0[3] *= bfhi(o.y); v1[0] *= bflo(o.z); v1[1] *= bfhi(o.z); v1[2] *= bflo(o.w); v1[3] *= bfhi(o.w); }
                        if (MODE == 3) { const u32x4 o = old[m2][bj];
                            float y[8] = {bflo(o.x), bfhi(o.x), bflo(o.y), bfhi(o.y), bflo(o.z), bfhi(o.z), bflo(o.w), bfhi(o.w)};
                            if (ycpart) {
#pragma unroll
                                for (int j = 0; j < 4; ++j) { y[j] *= rstd * gg[bj][0][j]; y[4 + j] *= rstd * gg[bj][1][j]; } }
#pragma unroll
                            for (int j = 0; j < 4; ++j) { v0[j] = silu_f(v0[j]) * y[j]; v1[j] = silu_f(v1[j]) * y[4 + j]; } }
                        u32x4 w; w.x = cvt_pk_bf16_asm(v0[0], v0[1]); w.y = cvt_pk_bf16_asm(v0[2], v0[3]); w.z = cvt_pk_bf16_asm(v1[0], v1[1]); w.w = cvt_pk_bf16_asm(v1[2], v1[3]);
                        *(u32x4*)p = w; } }
                if (MODE == 2 || MODE == 3) __builtin_amdgcn_sched_barrier(0); }
    }
};
struct EpiVBlk {
    static constexpr bool PERM = false;
    bf16_t* O; int NC;
    __device__ __forceinline__ void operator()(const f32x4 (&acc)[2][2][4][2], const Unit& u, int wr, int wc, int fr, int fq) const {
#pragma unroll
        for (int ai = 0; ai < 2; ++ai)
#pragma unroll
            for (int bj = 0; bj < 2; ++bj)
#pragma unroll
                for (int n = 0; n < 2; ++n) { const int C = u.pn * BM + bj * HALF + wc * 32 + n * 16 + fr;
#pragma unroll
                    for (int i = 0; i < 2; ++i) { const int grp = u.pm * 8 + ai * 4 + wr * 2 + i;
                        const f32x4 v0 = acc[ai][bj][2 * i][n], v1 = acc[ai][bj][2 * i + 1][n];
                        u32x4 w; w.x = cvt_pk_bf16_asm(v0[0], v0[1]); w.y = cvt_pk_bf16_asm(v0[2], v0[3]); w.z = cvt_pk_bf16_asm(v1[0], v1[1]); w.w = cvt_pk_bf16_asm(v1[2], v1[3]);
                        *(u32x4*)(O + ((size_t)grp * NC + C) * 32 + fq * 8) = w; } }
    }
};
struct EpiOut {
    static constexpr bool PERM = true;
    const float* resid; float* out; const float* gate;
    __device__ __forceinline__ void operator()(const f32x4 (&acc)[2][2][4][2], const Unit& u, int wr, int wc, int fr, int fq) const {
        const int row0 = u.pm * BM + wr * 64 + fr, col0 = u.pn * BM + wc * 32 + 8 * fq;
        const int b = (u.pm * BM) >> 11;
        f32x4 gv[2][2];
#pragma unroll
        for (int bj = 0; bj < 2; ++bj)
#pragma unroll
            for (int n = 0; n < 2; ++n) gv[bj][n] = *(const f32x4*)(gate + (size_t)b * 3072 + col0 + bj * HALF + n * 4);
#pragma unroll
        for (int ai = 0; ai < 2; ++ai)
#pragma unroll
            for (int mh = 0; mh < 2; ++mh) { f32x4 r[2][2][2];
#pragma unroll
                for (int m2 = 0; m2 < 2; ++m2) { const size_t ro = (size_t)(row0 + ai * HALF + (2 * mh + m2) * 16) * D + col0;
#pragma unroll
                    for (int bj = 0; bj < 2; ++bj)
#pragma unroll
                        for (int n = 0; n < 2; ++n) r[m2][bj][n] = *(const f32x4*)(resid + ro + bj * HALF + n * 4); }
                __builtin_amdgcn_sched_barrier(0);
#pragma unroll
                for (int m2 = 0; m2 < 2; ++m2) { const size_t ro = (size_t)(row0 + ai * HALF + (2 * mh + m2) * 16) * D + col0;
#pragma unroll
                    for (int bj = 0; bj < 2; ++bj)
#pragma unroll
                        for (int n = 0; n < 2; ++n) *(f32x4*)(out + ro + bj * HALF + n * 4) = r[m2][bj][n] + gv[bj][n] * acc[ai][bj][2 * mh + m2][n]; }
                __builtin_amdgcn_sched_barrier(0); }
    }
};
}

struct Args { const float* in[18]; float* out; unsigned char* ws; int ph_lo, ph_hi; };
enum { I_X = 0, I_C, I_ADAW, I_ADAB, I_NORMG, I_EINW, I_POOLW, I_POOLS, I_SGUG, I_SGUW, I_SGUB, I_EOUTW, I_OINW, I_GGW, I_GGB, I_GNG, I_OOUTW, I_FG };

__device__ __forceinline__ void transpose_tile(int wv, LAS float* tile, const float* src, int ld, int col0, int k0, bf16_t* dst, int ldd, int row0, const float* scale) {
    const int tid = opaque_tid(wv);
    { const int r = tid >> 4, c4 = tid & 15; f32x4 v[4];
#pragma unroll
      for (int i = 0; i < 4; ++i) v[i] = *(const f32x4*)(src + (size_t)(k0 + r + 32 * i) * ld + col0 + c4 * 4);
#pragma unroll
      for (int i = 0; i < 4; ++i)
#pragma unroll
          for (int j = 0; j < 4; ++j) tile[(r + 32 * i) * 65 + c4 * 4 + j] = v[i][j]; }
    __syncthreads();
    { const int n = tid >> 3, kc = (tid & 7) * 16; const float s = scale ? scale[n] : 1.0f;
#pragma unroll
      for (int h = 0; h < 2; ++h) { f32x4 a, b;
#pragma unroll
          for (int j = 0; j < 4; ++j) { a[j] = tile[(kc + 8 * h + j) * 65 + n] * s; b[j] = tile[(kc + 8 * h + 4 + j) * 65 + n] * s; }
          *(bf16x8*)(dst + (size_t)(row0 + n) * ldd + k0 + kc + 8 * h) = pack8(a, b); } }
    __syncthreads();
}

__device__ void phase_prep(int wv, const Args& a, LAS float* lds) {
    const int tid = opaque_tid(wv); unsigned char* ws = a.ws;
    for (int job = blockIdx.x; job < 192; job += gridDim.x) {
        {
            const int l = job / 96, cb = job % 96;
            LAS float* sc = lds; LAS float* red = lds + 16384;
            for (int i = tid; i < 16384; i += 512) sc[i] = silu_f(a.in[I_C][i]);
            __syncthreads();
            const int col = tid & 31, kg = tid >> 5;
            float acc[16];
#pragma unroll
            for (int b = 0; b < 16; ++b) acc[b] = 0.f;
            const float* w = a.in[I_ADAW] + (size_t)l * 1024 * 3072 + cb * 32 + col;
            for (int kk0 = 0; kk0 < 64; kk0 += 8) { float wv8[8];
#pragma unroll
                for (int u = 0; u < 8; ++u) wv8[u] = w[(size_t)(kg * 64 + kk0 + u) * 3072];
#pragma unroll
                for (int u = 0; u < 8; ++u) { const int k = kg * 64 + kk0 + u;
#pragma unroll
                    for (int b = 0; b < 16; ++b) acc[b] += sc[b * 1024 + k] * wv8[u]; } }
#pragma unroll
            for (int b = 0; b < 16; ++b) red[(kg * 16 + b) * 32 + col] = acc[b];
            __syncthreads();
            { const int b = tid >> 5; float s = a.in[I_ADAB][l * 3072 + cb * 32 + col];
#pragma unroll
              for (int q = 0; q < 16; ++q) s += red[(q * 16 + b) * 32 + col];
              ((float*)(ws + WS_ADA))[((size_t)l * 16 + b) * 3072 + cb * 32 + col] = s; }
            __syncthreads();
        }
    }
    struct TJob { const float* src; bf16_t* dst; const float* scale; int ld, col0, k0, ldd, row0; };
    auto decode = [&](int t) -> TJob {
        TJob j;
        if (t < 640) { const int nt = t / 8, kt = t % 8; j = TJob{a.in[I_EINW], (bf16_t*)(ws + WS_IN0T), nullptr, 5120, nt * 64, kt * 128, 1024, nt * 64}; }
        else if ((t -= 640) < 256) { const int nt = t / 16, kt = t % 16; j = TJob{a.in[I_EOUTW], (bf16_t*)(ws + WS_OUT0T), nullptr, 1024, nt * 64, kt * 128, 2048, nt * 64}; }
        else if ((t -= 256) < 896) { const int nt = t / 8, kt = t % 8; const int r0 = nt * 64;
            const int sc = r0 < 1024 ? r0 : r0 < 3072 ? 2064 + (r0 - 1024) : r0 < 4096 ? 1024 + (r0 - 3072) : r0 < 5120 ? 4112 + (r0 - 4096) : 5136 + (r0 - 5120);
            j = TJob{a.in[I_OINW], (bf16_t*)(ws + WS_IN1T), nullptr, 7184, sc, kt * 128, 1024, r0}; }
        else if ((t -= 896) < 256) { const int nt = t / 16, kt = t % 16; j = TJob{a.in[I_OOUTW], (bf16_t*)(ws + WS_OUT1T), nullptr, 1024, nt * 64, kt * 128, 2048, nt * 64}; }
        else { t -= 256; const int g = t >> 3, dt = (t >> 1) & 3, ct = t & 1;
            j = TJob{a.in[I_POOLW] + (size_t)g * 65536, (bf16_t*)(ws + WS_POOLT), a.in[I_POOLS] + g * 256 + dt * 64, 256, dt * 64, ct * 128, 256, g * 256 + dt * 64}; }
        return j; };
    {
        const int r = tid >> 4, c4 = tid & 15, n = tid >> 3, kc = (tid & 7) * 16;
        f32x4 v[4];
        int t = (int)((blockIdx.x + 64u) % gridDim.x);
        TJob cj = decode(t < 2080 ? t : 0);
        if (t < 2080) {
#pragma unroll
            for (int i = 0; i < 4; ++i) v[i] = *(const f32x4*)(cj.src + (size_t)(cj.k0 + r + 32 * i) * cj.ld + cj.col0 + c4 * 4); }
        for (; t < 2080; t += gridDim.x) {
#pragma unroll
            for (int i = 0; i < 4; ++i)
#pragma unroll
                for (int j = 0; j < 4; ++j) lds[(r + 32 * i) * 65 + c4 * 4 + j] = v[i][j];
            __syncthreads();
            const TJob pj = cj;
            const int tn = t + (int)gridDim.x;
            if (tn < 2080) { cj = decode(tn);
#pragma unroll
                for (int i = 0; i < 4; ++i) v[i] = *(const f32x4*)(cj.src + (size_t)(cj.k0 + r + 32 * i) * cj.ld + cj.col0 + c4 * 4); }
            const float s = pj.scale ? pj.scale[n] : 1.0f;
#pragma unroll
            for (int h = 0; h < 2; ++h) { f32x4 x, y;
#pragma unroll
                for (int j = 0; j < 4; ++j) { x[j] = lds[(kc + 8 * h + j) * 65 + n] * s; y[j] = lds[(kc + 8 * h + 4 + j) * 65 + n] * s; }
                *(bf16x8*)(pj.dst + (size_t)(pj.row0 + n) * pj.ldd + pj.k0 + kc + 8 * h) = pack8(x, y); }
            __syncthreads();
        }
    }
    float* sw = (float*)(ws + WS_SGUW);
    for (int i = blockIdx.x * 512 + tid; i < 8 * 128 * 128; i += gridDim.x * 512) { const int s = i & 127, t = (i >> 7) & 127; sw[i] = (s <= t) ? a.in[I_SGUW][i] : 0.f; }
}

__device__ void phase_h(int wv, const float* xin, const float* normg, const float* ada, bf16_t* H, bool with_glr, const float* oinw, float* GLR, LAS float* lds) {
    const int tid = opaque_tid(wv), lane = tid & 63, wave = tid >> 6;
    if (with_glr) { for (int i = tid; i < 16384; i += 512) { const int c = i >> 4, j = i & 15; lds[j * 1024 + c] = oinw[(size_t)c * 7184 + 2048 + j]; } __syncthreads(); }
    f32x4 gh[4];
#pragma unroll
    for (int i = 0; i < 4; ++i) gh[i] = *(const f32x4*)(normg + i * 256 + lane * 4);
    for (int r0 = (blockIdx.x * 8 + wave) * 2; r0 < M; r0 += gridDim.x * 16) {
        f32x4 xr[2][4], sc4[4], sh4[4];
        { const float* ab0 = ada + (size_t)(r0 >> 11) * 3072;
#pragma unroll
          for (int i = 0; i < 4; ++i) { sc4[i] = *(const f32x4*)(ab0 + 1024 + i * 256 + lane * 4); sh4[i] = *(const f32x4*)(ab0 + i * 256 + lane * 4); } }
#pragma unroll
        for (int u = 0; u < 2; ++u)
#pragma unroll
            for (int i = 0; i < 4; ++i) xr[u][i] = *(const f32x4*)(xin + (size_t)(r0 + u) * D + i * 256 + lane * 4);
        __builtin_amdgcn_sched_barrier(0);
#pragma unroll
        for (int u = 0; u < 2; ++u) {
        const int r = r0 + u;
        const int b = r >> 11; const float* ab = ada + (size_t)b * 3072;
        f32x4 x4[4]; float ssq = 0.f;
#pragma unroll
        for (int i = 0; i < 4; ++i) { x4[i] = xr[u][i]; ssq += x4[i][0] * x4[i][0] + x4[i][1] * x4[i][1] + x4[i][2] * x4[i][2] + x4[i][3] * x4[i][3]; }
        ssq = wave_sum(ssq);
        const float rstd = __builtin_amdgcn_rsqf(ssq * (1.0f / 1024.0f) + EPS);
#pragma unroll
        for (int i = 0; i < 4; ++i) { const int c = i * 256 + lane * 4;
            x4[i] = x4[i] * rstd * gh[i] * (sc4[i] + 1.0f) + sh4[i];
            u32x2 w; w.x = cvt_pk_bf16(x4[i][0], x4[i][1]); w.y = cvt_pk_bf16(x4[i][2], x4[i][3]);
            *(u32x2*)(H + (size_t)r * D + c) = w; }
        if (with_glr) {
            float v[16]; int lo = lane * 4; asm volatile("" : "+v"(lo));
#pragma unroll
            for (int qg = 0; qg < 8; ++qg) { f32x4 wq[2][4];
#pragma unroll
                for (int qq = 0; qq < 2; ++qq)
#pragma unroll
                    for (int i = 0; i < 4; ++i) wq[qq][i] = *(const LAS f32x4*)(lds + (2 * qg + qq) * 1024 + i * 256 + lo);
                __builtin_amdgcn_sched_barrier(0);
#pragma unroll
                for (int qq = 0; qq < 2; ++qq) { float s = 0.f;
#pragma unroll
                    for (int i = 0; i < 4; ++i) s += x4[i][0] * wq[qq][i][0] + x4[i][1] * wq[qq][i][1] + x4[i][2] * wq[qq][i][2] + x4[i][3] * wq[qq][i][3];
                    v[2 * qg + qq] = s; }
                __builtin_amdgcn_sched_barrier(0); }
#define GLR_STEP(NN, MASK) do { float rcv[NN]; const bool up = (lane & (MASK)) != 0; \
                _Pragma("unroll") for (int i = 0; i < (NN); ++i) { const float lo_ = v[i], hi_ = v[i + (NN)]; rcv[i] = __shfl_xor(up ? lo_ : hi_, (MASK)); } \
                _Pragma("unroll") for (int i = 0; i < (NN); ++i) { const float lo_ = v[i], hi_ = v[i + (NN)]; v[i] = (up ? hi_ : lo_) + rcv[i]; } } while (0)
            GLR_STEP(8, 32); GLR_STEP(4, 16); GLR_STEP(2, 8); GLR_STEP(1, 4);
#undef GLR_STEP
            v[0] += __shfl_xor(v[0], 2); v[0] += __shfl_xor(v[0], 1);
            if ((lane & 3) == 0) GLR[(size_t)r * 16 + (lane >> 2)] = v[0];
        }
        }
    }
    __syncthreads();
}

__device__ void phase_poolp(int wv, const bf16_t* AU, bf16_t* P) {
    const int tid = opaque_tid(wv);
#pragma unroll 1
    for (int j2 = tid; ; j2 += 512) { const int L = (int)blockIdx.x + (j2 >> 10) * (int)gridDim.x; if (L >= 512) break; const int job = j2 & 1023;
        const int c8 = (L & 3) * 32 + (job & 31), seg = (L >> 2) * 32 + (job >> 5), T0 = seg * 8, col = c8 * 8, g = col >> 8, w = 2 << g, tin = T0 & 2047;
        const bf16_t* base = AU + (size_t)T0 * 2048 + col;
        const u32x4 zero = {0u, 0u, 0u, 0u};
        u32x4 prev[15], curv[8], oldv[8];
#pragma unroll
        for (int i = 1; i < 16; ++i) { const bool ok = (i < w && tin - i >= 0); prev[i - 1] = *(const u32x4*)(base - (ptrdiff_t)(ok ? i : 0) * 2048); }
#pragma unroll
        for (int tt = 0; tt < 8; ++tt) curv[tt] = *(const u32x4*)(base + (size_t)tt * 2048);
        oldv[0] = zero;
#pragma unroll
        for (int tt = 1; tt < 8; ++tt) { const bool ok = (tin + tt - w >= 0); oldv[tt] = *(const u32x4*)(base + (ptrdiff_t)(ok ? tt - w : 0) * 2048); }
        __builtin_amdgcn_sched_barrier(0);
        float sum[8];
#pragma unroll
        for (int j = 0; j < 8; ++j) sum[j] = 0.f;
#pragma unroll
        for (int i = 0; i < 15; ++i) { const u32x4 v = prev[i]; const float mk = ((i + 1) < w && tin - (i + 1) >= 0) ? 1.0f : 0.0f;
            sum[0] += mk * bflo(v.x); sum[1] += mk * bfhi(v.x); sum[2] += mk * bflo(v.y); sum[3] += mk * bfhi(v.y); sum[4] += mk * bflo(v.z); sum[5] += mk * bfhi(v.z); sum[6] += mk * bflo(v.w); sum[7] += mk * bfhi(v.w); }
#pragma unroll
        for (int tt = 0; tt < 8; ++tt) { const int pos = tin + tt;
            const u32x4 v = curv[tt];
            const float cur[8] = {bflo(v.x), bfhi(v.x), bflo(v.y), bfhi(v.y), bflo(v.z), bfhi(v.z), bflo(v.w), bfhi(v.w)};
#pragma unroll
            for (int j = 0; j < 8; ++j) sum[j] += cur[j];
            { const u32x4 o = oldv[tt]; const float mk = (tt > 0 && tin + tt - w >= 0) ? 1.0f : 0.0f;
              sum[0] -= mk * bflo(o.x); sum[1] -= mk * bfhi(o.x); sum[2] -= mk * bflo(o.y); sum[3] -= mk * bfhi(o.y); sum[4] -= mk * bflo(o.z); sum[5] -= mk * bfhi(o.z); sum[6] -= mk * bflo(o.w); sum[7] -= mk * bfhi(o.w); }
            const float inv = 1.0f / (float)(pos + 1 < w ? pos + 1 : w);
            u32x4 o; o.x = cvt_pk_bf16(sum[0] * inv - cur[0], sum[1] * inv - cur[1]); o.y = cvt_pk_bf16(sum[2] * inv - cur[2], sum[3] * inv - cur[3]);
            o.z = cvt_pk_bf16(sum[4] * inv - cur[4], sum[5] * inv - cur[5]); o.w = cvt_pk_bf16(sum[6] * inv - cur[6], sum[7] * inv - cur[7]);
            *(u32x4*)(P + (size_t)(T0 + tt) * 1024 + col) = o; }
    }
}

__device__ void phase_sgu(int wv, const bf16_t* AU, const bf16_t* V0, bf16_t* Y0, const float* SGUW, const float* sgub, const float* sgug, LAS float* lds) {
    const int tid = opaque_tid(wv), lane = tid & 63, hh = tid >> 6, fr = lane & 15, fq = lane >> 4;
    for (int chunk = blockIdx.x; chunk < M / 128; chunk += gridDim.x) {
        const int tok0 = chunk * 128;
        {
          const int g = tid >> 7, kq = (tid >> 5) & 3, j = tid & 31;
          const bf16_t* vp = V0 + ((size_t)((tok0 >> 5) + g) * 1024 + j) * 32 + kq * 8;
          float ac[8];
#pragma unroll
          for (int e = 0; e < 8; ++e) ac[e] = 0.f;
          for (int ib = 0; ib < 4; ++ib) { u32x4 vv[8];
#pragma unroll
              for (int i = 0; i < 8; ++i) vv[i] = *(const u32x4*)(vp + (size_t)(8 * ib + i) * 32 * 32);
              __builtin_amdgcn_sched_barrier(0);
#pragma unroll
              for (int i = 0; i < 8; ++i) { const u32x4 v = vv[i];
                  const float f0 = bflo(v.x), f1 = bfhi(v.x), f2 = bflo(v.y), f3 = bfhi(v.y), f4 = bflo(v.z), f5 = bfhi(v.z), f6 = bflo(v.w), f7 = bfhi(v.w);
                  ac[0] += f0 * f0; ac[1] += f1 * f1; ac[2] += f2 * f2; ac[3] += f3 * f3; ac[4] += f4 * f4; ac[5] += f5 * f5; ac[6] += f6 * f6; ac[7] += f7 * f7; } }
#pragma unroll
          for (int e = 0; e < 8; ++e) {
#pragma unroll
              for (int m = 16; m >= 1; m >>= 1) ac[e] += __shfl_xor(ac[e], m); }
          if (j == 0) {
#pragma unroll
              for (int e = 0; e < 8; ++e) lds[32 * g + 16 * (e >> 2) + 4 * kq + (e & 3)] = __builtin_amdgcn_rsqf(ac[e] * (1.0f / 1024.0f) + EPS); } }
        __syncthreads();
        f32x4 gsg[8];
#pragma unroll
        for (int n = 0; n < 8; ++n) gsg[n] = *(const f32x4*)(sgug + hh * 128 + 16 * n + 4 * fq);
        for (int mp = 0; mp < 4; ++mp) {
            f32x4 acc[2][8];
#pragma unroll
            for (int i = 0; i < 2; ++i)
#pragma unroll
                for (int n = 0; n < 8; ++n) acc[i][n] = (f32x4){0.f, 0.f, 0.f, 0.f};
            for (int ks = 0; ks <= mp; ++ks) {
                const int s0 = 32 * ks + 4 * fq;
                bf16x8 bfv[8];
#pragma unroll
                for (int n = 0; n < 8; ++n) bfv[n] = *(const bf16x8*)(V0 + ((size_t)((tok0 >> 5) + ks) * 1024 + hh * 128 + 16 * n + fr) * 32 + fq * 8);
                const f32x4 ra = *(const LAS f32x4*)(lds + s0), rb = *(const LAS f32x4*)(lds + s0 + 16);
                f32x4 wl[2][2];
#pragma unroll
                for (int i = 0; i < 2; ++i) { const float* wrow = SGUW + ((size_t)hh * 128 + 16 * (2 * mp + i) + fr) * 128; wl[i][0] = *(const f32x4*)(wrow + s0); wl[i][1] = *(const f32x4*)(wrow + s0 + 16); }
                __builtin_amdgcn_sched_barrier(0);
                bf16x8 af[2];
#pragma unroll
                for (int i = 0; i < 2; ++i) af[i] = pack8(wl[i][0] * ra, wl[i][1] * rb);
#pragma unroll
                for (int n = 0; n < 8; ++n) { acc[0][n] = MFMA16(bfv[n], af[0], acc[0][n]); acc[1][n] = MFMA16(bfv[n], af[1], acc[1][n]); }
            }
#pragma unroll
            for (int i = 0; i < 2; ++i) { const int t = 16 * (2 * mp + i) + fr; const float bb = sgub[hh * 128 + t];
                u32x2 uu[8], GG[8];
#pragma unroll
                for (int n = 0; n < 8; ++n) { const int col = hh * 128 + 16 * n + 4 * fq;
                    uu[n] = *(const u32x2*)(AU + (size_t)(tok0 + t) * 2048 + 1024 + col); GG[n] = *(const u32x2*)(Y0 + (size_t)(tok0 + t) * 2048 + 1024 + col); }
                __builtin_amdgcn_sched_barrier(0);
#pragma unroll
                for (int n = 0; n < 8; ++n) { const int col = hh * 128 + 16 * n + 4 * fq;
                    const f32x4 g = gsg[n];
                    bf16_t* yp = Y0 + (size_t)(tok0 + t) * 2048 + 1024 + col;
                    const u32x2 u = uu[n], G = GG[n];
                    const f32x4 z = acc[i][n] * g + bb;
                    u32x2 o; o.x = cvt_pk_bf16(z[0] * bflo(u.x) * bflo(G.x), z[1] * bfhi(u.x) * bfhi(G.x)); o.y = cvt_pk_bf16(z[2] * bflo(u.y) * bflo(G.y), z[3] * bfhi(u.y) * bfhi(G.y));
                    *(u32x2*)yp = o; } }
        }
        __syncthreads();
    }
}

typedef short s16x4 __attribute__((ext_vector_type(4)));
constexpr int GP_GLR = 0, GP_TOT = 4096;
__device__ void phase_glapre(int wv, bf16_t* QK, const float* GLR, float* EB, const float* ggw, const float* ggb, LAS unsigned char* lds) {
    const int tid = opaque_tid(wv);
    LAS float* sGLR = (LAS float*)(lds + GP_GLR); LAS float* sTOT = (LAS float*)(lds + GP_TOT);
    const int k = tid & 127, sq = tid >> 7;
    f32x4 pg = (f32x4){0.f, 0.f, 0.f, 0.f}; unsigned short pq[16], pkk[16];
#define GP_LOAD(itt) do { const int _b = (itt) >> 7, _hh = ((itt) >> 5) & 3, _n = (itt) & 31, _t0 = _b * 2048 + _n * 64; \
        if (tid < 256) pg = *(const f32x4*)(GLR + (size_t)_t0 * 16 + tid * 4); \
        _Pragma("unroll") for (int i = 0; i < 16; ++i) { const size_t ro = (size_t)(_t0 + 16 * sq + i) * 4096 + _hh * 128 + k; pq[i] = QK[ro]; pkk[i] = QK[ro + 512]; } } while (0)
    if ((int)blockIdx.x < 2048) GP_LOAD((int)blockIdx.x);
    float gw[16], gb = 0.f; int hh_ld = -1;
#pragma unroll
    for (int j = 0; j < 16; ++j) gw[j] = 0.f;
    for (int it = blockIdx.x; it < 2048; it += gridDim.x) {
        const int b = it >> 7, hh = (it >> 5) & 3, n = it & 31, col = hh * 128 + k, tok0 = b * 2048 + n * 64;
        if (hh != hh_ld) { hh_ld = hh;
#pragma unroll
            for (int j = 0; j < 16; ++j) gw[j] = ggw[j * 512 + col];
            gb = ggb[col]; }
        if (tid < 256) *(LAS f32x4*)(sGLR + tid * 4) = pg;
        float qv[16], kv[16];
#pragma unroll
        for (int i = 0; i < 16; ++i) { qv[i] = bf2f(pq[i]); kv[i] = bf2f(pkk[i]); }
        __syncthreads();
        if (it + (int)gridDim.x < 2048) GP_LOAD(it + (int)gridDim.x);
        float c[16]; float run = 0.f;
#pragma unroll
        for (int i = 0; i < 16; ++i) { const int s = 16 * sq + i; float dot = gb;
#pragma unroll
            for (int j4 = 0; j4 < 4; ++j4) { const f32x4 gl = *(const LAS f32x4*)(sGLR + s * 16 + j4 * 4); dot += gl[0] * gw[j4 * 4] + gl[1] * gw[j4 * 4 + 1] + gl[2] * gw[j4 * 4 + 2] + gl[3] * gw[j4 * 4 + 3]; }
            run += logsig2_f(dot * 1.4426950408889634f) * (1.0f / 16.0f); c[i] = run; }
        sTOT[sq * 128 + k] = run;
        __syncthreads();
        const float t0 = sTOT[k], t1 = sTOT[128 + k], t2 = sTOT[256 + k], t3 = sTOT[384 + k];
        const float pre = (sq > 0 ? t0 : 0.f) + (sq > 1 ? t1 : 0.f) + (sq > 2 ? t2 : 0.f), blast = t0 + t1 + t2 + t3;
#pragma unroll
        for (int i = 0; i < 16; ++i) { const size_t ro = (size_t)(tok0 + 16 * sq + i) * 4096 + col; const float bc = pre + c[i];
            QK[ro] = f2bf(qv[i] * 0.08838834764831845f * __builtin_amdgcn_exp2f(bc));
            QK[ro + 512] = f2bf(kv[i] * __builtin_amdgcn_exp2f(-bc)); }
        if (sq == 0) EB[(size_t)it * 128 + k] = __builtin_amdgcn_exp2f(blast);
        __syncthreads();
    }
#undef GP_LOAD
}

constexpr int G2_BUF = 43520, G2_QD = 0, G2_KI = 17408, G2_VT = 34816, G2_EB = 43008, G2_ST = 2 * G2_BUF, G2_STB = 17408;
__device__ void phase_gla2(int wv, const bf16_t* QK, const bf16_t* V1, bf16_t* YC  , const float* EB, float* SSQ, LAS unsigned char* lds) {
    const int tid = opaque_tid(wv), lane = tid & 63, fr = lane & 15, fq = lane >> 4;
    for (int item = blockIdx.x; item < 256; item += gridDim.x) {
        const int b = item >> 4, hh = (item >> 2) & 3, vs = item & 3;
        f32x4 S[2][4];
#pragma unroll
        for (int kk = 0; kk < 2; ++kk)
#pragma unroll
            for (int i = 0; i < 4; ++i) S[kk][i] = (f32x4){0.f, 0.f, 0.f, 0.f};
        u32x4 pqd[2], pki[2], pvv; float peb = 0.f;
#define G2_LOAD(nn) do { const int _t0 = b * 2048 + (nn) * 64; \
            _Pragma("unroll") for (int i = 0; i < 2; ++i) { const int ch = tid + 512 * i, s = ch >> 4, c16 = ch & 15; const bf16_t* p = QK + (size_t)(_t0 + s) * 4096 + hh * 128 + c16 * 8; \
                pqd[i] = *(const u32x4*)p; pki[i] = *(const u32x4*)(p + 512); } \
            { const int grp = tid >> 8, v = (tid >> 2) & 63, ch = tid & 3; pvv = *(const u32x4*)(V1 + ((size_t)((_t0 >> 5) + grp) * 2048 + hh * 256 + vs * 64 + v) * 32 + ch * 8); } \
            if (tid < 128) peb = EB[((size_t)((b * 4 + hh) * 32 + (nn))) * 128 + tid]; } while (0)
#define G2_STORE(bb) do { LAS unsigned char* _q = lds + (bb) * G2_BUF; \
            _Pragma("unroll") for (int i = 0; i < 2; ++i) { const int ch = tid + 512 * i, s = ch >> 4, c16 = ch & 15; \
                *(LAS u32x4*)((LAS bf16_t*)(_q + G2_QD) + s * 136 + c16 * 8) = pqd[i]; *(LAS u32x4*)((LAS bf16_t*)(_q + G2_KI) + s * 136 + c16 * 8) = pki[i]; } \
            { const int grp = tid >> 8, v = (tid >> 2) & 63, ch = tid & 3; *(LAS u32x4*)((LAS bf16_t*)(_q + G2_VT) + (grp * 64 + v) * 32 + ch * 8) = pvv; } \
            if (tid < 128) ((LAS float*)(_q + G2_EB))[tid] = peb; } while (0)
        G2_LOAD(0);
        __syncthreads();
        for (int i = tid; i < G2_STB / 4; i += 512) ((LAS unsigned*)(lds + G2_ST))[i] = 0u;
        G2_STORE(0);
        G2_LOAD(1);
        __syncthreads();
        for (int n = 0; n < 32; ++n) {
            const int tok0 = b * 2048 + n * 64;
            LAS unsigned char* cb = lds + (n & 1) * G2_BUF;
            LAS bf16_t* sQD = (LAS bf16_t*)(cb + G2_QD); LAS bf16_t* sKI = (LAS bf16_t*)(cb + G2_KI); LAS bf16_t* sVT = (LAS bf16_t*)(cb + G2_VT); LAS float* sEB = (LAS float*)(cb + G2_EB);
            LAS bf16_t* stR = (LAS bf16_t*)(lds + G2_ST + (n & 1) * G2_STB);
            LAS bf16_t* stW = (LAS bf16_t*)(lds + G2_ST + ((n + 1) & 1) * G2_STB);
            if (wv < 4) {
              const int tt = wv;
              bf16x8 qf[4];
#pragma unroll
              for (int ks = 0; ks < 4; ++ks) qf[ks] = *(const LAS bf16x8*)(sQD + (16 * tt + fr) * 136 + 32 * ks + 8 * fq);
              f32x4 att[4];
#pragma unroll
              for (int st = 0; st < 4; ++st) { att[st] = (f32x4){0.f, 0.f, 0.f, 0.f};
                  if (st <= tt) {
#pragma unroll
                      for (int ks = 0; ks < 4; ++ks) att[st] = MFMA16(*(const LAS bf16x8*)(sKI + (16 * st + fr) * 136 + 32 * ks + 8 * fq), qf[ks], att[st]);
                      if (st == tt) {
#pragma unroll
                          for (int r = 0; r < 4; ++r) if (4 * fq + r > fr) att[st][r] = 0.f; } } }
              const bf16x8 wf0 = pack8(att[0], att[1]), wf1 = pack8(att[2], att[3]);
              float ss = 0.f;
#pragma unroll
              for (int vt = 0; vt < 4; ++vt) { f32x4 o = (f32x4){0.f, 0.f, 0.f, 0.f};
                  o = MFMA16(*(const LAS bf16x8*)(sVT + (16 * vt + fr) * 32 + fq * 8), wf0, o);
                  o = MFMA16(*(const LAS bf16x8*)(sVT + (64 + 16 * vt + fr) * 32 + fq * 8), wf1, o);
#pragma unroll
                  for (int ks = 0; ks < 4; ++ks) o = MFMA16(*(const LAS bf16x8*)(stR + (16 * vt + fr) * 136 + 32 * ks + 8 * fq), qf[ks], o);
                  u32x2 ow; ow.x = cvt_pk_bf16(o[0], o[1]); ow.y = cvt_pk_bf16(o[2], o[3]);
                  *(u32x2*)(YC + (size_t)(tok0 + 16 * tt + fr) * 4096 + hh * 256 + vs * 64 + 16 * vt + 4 * fq) = ow;
                  ss += o[0] * o[0] + o[1] * o[1] + o[2] * o[2] + o[3] * o[3]; }
              ss += __shfl_xor(ss, 16); ss += __shfl_xor(ss, 32);
              if (lane < 16) { float* sp = SSQ + ((size_t)(tok0 + 16 * tt + fr) * 4 + hh) * 8 + vs * 2; sp[0] = ss; sp[1] = 0.f; }
            } else {
              const int kb = wv - 4;
              bf16x8 vf[2][4];
#pragma unroll
              for (int g2 = 0; g2 < 2; ++g2)
#pragma unroll
                  for (int vt = 0; vt < 4; ++vt) vf[g2][vt] = *(const LAS bf16x8*)(sVT + (64 * g2 + 16 * vt + fr) * 32 + fq * 8);
#pragma unroll
              for (int kk = 0; kk < 2; ++kk) { const int kt = 2 * kb + kk;
                  const f32x4 eb = *(const LAS f32x4*)(sEB + 16 * kt + 4 * fq);
                  bf16x8 ka[2];
#pragma unroll
                  for (int g2 = 0; g2 < 2; ++g2) {
                      const s16x4 lo = __builtin_amdgcn_ds_read_tr16_b64_v4i16((LAS s16x4*)(sKI + (32 * g2 + 4 * fq + (fr >> 2)) * 136 + 16 * kt + 4 * (fr & 3)));
                      const s16x4 hi = __builtin_amdgcn_ds_read_tr16_b64_v4i16((LAS s16x4*)(sKI + (32 * g2 + 16 + 4 * fq + (fr >> 2)) * 136 + 16 * kt + 4 * (fr & 3)));
                      ka[g2] = (bf16x8){lo[0], lo[1], lo[2], lo[3], hi[0], hi[1], hi[2], hi[3]}; }
#pragma unroll
                  for (int vt = 0; vt < 4; ++vt) {
                      S[kk][vt] = MFMA16(ka[0], vf[0][vt], S[kk][vt]);
                      S[kk][vt] = MFMA16(ka[1], vf[1][vt], S[kk][vt]);
                      S[kk][vt] = S[kk][vt] * eb;
                      u32x2 ow; ow.x = cvt_pk_bf16(S[kk][vt][0], S[kk][vt][1]); ow.y = cvt_pk_bf16(S[kk][vt][2], S[kk][vt][3]);
                      *(LAS u32x2*)(stW + (16 * vt + fr) * 136 + 16 * kt + 4 * fq) = ow; } } }
            if (n < 31) { G2_STORE((n + 1) & 1); if (n < 30) G2_LOAD(n + 2); }
            __syncthreads();
        }
#undef G2_LOAD
#undef G2_STORE
    }
}

constexpr int SB_K = 0, SB_V = 17408, SB_BUF = 16896;
__device__ void phase_sb(int wv, bf16_t* QK, const bf16_t* V1, LAS unsigned char* lds) {
    const int tid = opaque_tid(wv), lane = tid & 63, w = tid >> 6, fr = lane & 15, fq = lane >> 4;
    LAS bf16_t* sK = (LAS bf16_t*)(lds + SB_K); LAS bf16_t* sV = (LAS bf16_t*)(lds + SB_V); LAS int* sDone = (LAS int*)(lds + 2 * SB_BUF * 2); int it = 0;
    const float scale = 0.08838834764831845f * 1.4426950408889634f;
    for (int cc = blockIdx.x; cc < 256; cc += gridDim.x) {
        const int ph = cc >> 1, half = cc & 1, b = ph >> 3, hh = ph & 7;
        bf16x8 nq[4]; u32x4 nk[2], nv[2];
#define SB_QB(jj) (half ? (((jj) & 1) ? 4 + ((jj) >> 1) : 11 - ((jj) >> 1)) : (((jj) & 1) ? ((jj) >> 1) : 15 - ((jj) >> 1)))
#define SB_NEXT(jj) do { const int _qb = SB_QB(jj), _kb = 2 * _qb + 1; const size_t _qr = (size_t)(b * 2048 + 128 * _qb + 16 * w + fr) * 4096 + 1024 + hh * 128; \
            _Pragma("unroll") for (int ks = 0; ks < 4; ++ks) nq[ks] = *(const bf16x8*)(QK + _qr + 32 * ks + 8 * fq); \
            _Pragma("unroll") for (int i = 0; i < 2; ++i) { const int ch = tid + 512 * i; \
                { const int s = ch >> 4, c16 = ch & 15; nk[i] = *(const u32x4*)(QK + (size_t)(b * 2048 + 64 * _kb + s) * 4096 + 2048 + hh * 128 + c16 * 8); } \
                { const int grp = ch >> 9, d = (ch >> 2) & 127, c4 = ch & 3; nv[i] = *(const u32x4*)(V1 + ((size_t)(((b * 2048 + 64 * _kb) >> 5) + grp) * 2048 + 1024 + hh * 128 + d) * 32 + c4 * 8); } } } while (0)
        SB_NEXT(0);
        for (int j = 0; j < 8; ++j) {
            const int qb = SB_QB(j);
            const int tq = 128 * qb + 16 * w + fr;
            const size_t qrow = (size_t)(b * 2048 + tq) * 4096 + 1024 + hh * 128;
            bf16x8 qf[4];
#pragma unroll
            for (int ks = 0; ks < 4; ++ks) qf[ks] = nq[ks];
            u32x4 pk[2], pv[2];
            pk[0] = nk[0]; pk[1] = nk[1]; pv[0] = nv[0]; pv[1] = nv[1];
            if (j < 7) SB_NEXT(j + 1);
            f32x4 oacc[8];
#pragma unroll
            for (int d = 0; d < 8; ++d) oacc[d] = (f32x4){0.f, 0.f, 0.f, 0.f};
            float R = 0.f;
#define SB_LOAD(kbb) do { _Pragma("unroll") for (int i = 0; i < 2; ++i) { const int ch = tid + 512 * i; \
                { const int s = ch >> 4, c16 = ch & 15; pk[i] = *(const u32x4*)(QK + (size_t)(b * 2048 + 64 * (kbb) + s) * 4096 + 2048 + hh * 128 + c16 * 8); } \
                { const int grp = ch >> 9, d = (ch >> 2) & 127, c4 = ch & 3; pv[i] = *(const u32x4*)(V1 + ((size_t)(((b * 2048 + 64 * (kbb)) >> 5) + grp) * 2048 + 1024 + hh * 128 + d) * 32 + c4 * 8); } } } while (0)
#define SB_STORE(bufo) do { _Pragma("unroll") for (int i = 0; i < 2; ++i) { const int ch = tid + 512 * i; \
                { const int s = ch >> 4, c16 = ch & 15; *(LAS u32x4*)(sK + (bufo) + s * 136 + c16 * 8) = pk[i]; } \
                { const int grp = ch >> 9, d = (ch >> 2) & 127, c4 = ch & 3; *(LAS u32x4*)(sV + (bufo) + (grp * 128 + d) * 32 + c4 * 8) = pv[i]; } } } while (0)
            __syncthreads();
            SB_STORE(0);
            SB_LOAD(2 * qb);
            int cur = 0;
            for (int kb = 2 * qb + 1; kb >= 0; --kb) {
                const bool wdone = (__ballot(R >= -160.0f) == 0ull);
                if (lane == 0) sDone[(it & 1) * 8 + w] = wdone ? 0 : 1;
                __syncthreads();
                { const LAS int* dn = sDone + (it & 1) * 8; const int any = dn[0] | dn[1] | dn[2] | dn[3] | dn[4] | dn[5] | dn[6] | dn[7]; ++it; if (!any) break; }
                const int bo = cur * SB_BUF;
                if (kb > 0) { SB_STORE((cur ^ 1) * SB_BUF); if (kb > 1) SB_LOAD(kb - 2); }
                cur ^= 1;
                if (wdone || 64 * kb >= 128 * qb + 16 * w + 15) continue;
                f32x4 zt[4];
#pragma unroll
                for (int st = 0; st < 4; ++st) zt[st] = (f32x4){0.f, 0.f, 0.f, 0.f};
#pragma unroll
                for (int kh = 0; kh < 2; ++kh) {
                    bf16x8 kf[4][2];
#pragma unroll
                    for (int st = 0; st < 4; ++st)
#pragma unroll
                        for (int k2 = 0; k2 < 2; ++k2) kf[st][k2] = *(const LAS bf16x8*)(sK + bo + (16 * st + fr) * 136 + 32 * (2 * kh + k2) + 8 * fq);
                    __builtin_amdgcn_sched_barrier(0);
#pragma unroll
                    for (int k2 = 0; k2 < 2; ++k2)
#pragma unroll
                        for (int st = 0; st < 4; ++st) zt[st] = MFMA16(kf[st][k2], qf[2 * kh + k2], zt[st]);
                    __builtin_amdgcn_sched_barrier(0); }
                float lb[4][4], l1[4][4], P[4], sfx[4], TT[4];
#pragma unroll
                for (int st = 0; st < 4; ++st) { P[st] = 0.f;
#pragma unroll
                    for (int r = 0; r < 4; ++r) { const float zz = zt[st][r] * scale; const float lbv = logsig2_f(zz);
                        const bool strict = (64 * kb + 16 * st + 4 * fq + r) < tq;
                        lb[st][r] = strict ? lbv : -1.0e30f; l1[st][r] = strict ? (lbv - zz) : 0.f; P[st] += l1[st][r]; } }
#pragma unroll
                for (int st = 0; st < 4; ++st) { const float x16 = __shfl_xor(P[st], 16), x32 = __shfl_xor(P[st], 32), x48 = __shfl_xor(x16, 32);
                    TT[st] = P[st] + x16 + x32 + x48;
                    sfx[st] = fq == 0 ? (x16 + x32 + x48) : fq == 1 ? (x32 + x48) : fq == 2 ? x16 : 0.f; }
                float run = R;
#pragma unroll
                for (int st = 3; st >= 0; --st) { float a = run + sfx[st];
#pragma unroll
                    for (int r = 3; r >= 0; --r) { zt[st][r] = __builtin_amdgcn_exp2f(lb[st][r] + a); a += l1[st][r]; }
                    run += TT[st]; }
                R = run;
                const bf16x8 wf0 = pack8(zt[0], zt[1]), wf1 = pack8(zt[2], zt[3]);
#pragma unroll
                for (int dh = 0; dh < 2; ++dh) {
                    bf16x8 vf0[4], vf1[4];
#pragma unroll
                    for (int d4 = 0; d4 < 4; ++d4) { vf0[d4] = *(const LAS bf16x8*)(sV + bo + (16 * (4 * dh + d4) + fr) * 32 + fq * 8); vf1[d4] = *(const LAS bf16x8*)(sV + bo + (128 + 16 * (4 * dh + d4) + fr) * 32 + fq * 8); }
                    __builtin_amdgcn_sched_barrier(0);
#pragma unroll
                    for (int d4 = 0; d4 < 4; ++d4) oacc[4 * dh + d4] = MFMA16(vf0[d4], wf0, oacc[4 * dh + d4]);
#pragma unroll
                    for (int d4 = 0; d4 < 4; ++d4) oacc[4 * dh + d4] = MFMA16(vf1[d4], wf1, oacc[4 * dh + d4]);
                    __builtin_amdgcn_sched_barrier(0); }
            }
#pragma unroll
            for (int d = 0; d < 8; ++d) { u32x2 ow; ow.x = cvt_pk_bf16(oacc[d][0], oacc[d][1]); ow.y = cvt_pk_bf16(oacc[d][2], oacc[d][3]);
                *(u32x2*)(QK + qrow + 16 * d + 4 * fq) = ow; }
        }
    }
#undef SB_LOAD
#undef SB_STORE
#undef SB_NEXT
#undef SB_QB
    __syncthreads();
}

__device__ void phase_final(int wv, float* out, const float* g) {
    const int tid = opaque_tid(wv), lane = tid & 63, wave = tid >> 6;
    f32x4 gf[4];
#pragma unroll
    for (int i = 0; i < 4; ++i) gf[i] = *(const f32x4*)(g + i * 256 + lane * 4);
    for (int r0 = (blockIdx.x * 8 + wave) * 4; r0 < M; r0 += gridDim.x * 32) {
        f32x4 xr[4][4];
#pragma unroll
        for (int u = 0; u < 4; ++u)
#pragma unroll
            for (int i = 0; i < 4; ++i) xr[u][i] = *(const f32x4*)(out + (size_t)(r0 + u) * D + i * 256 + lane * 4);
        __builtin_amdgcn_sched_barrier(0);
#pragma unroll
        for (int u = 0; u < 4; ++u) { float ssq = 0.f;
#pragma unroll
            for (int i = 0; i < 4; ++i) ssq += xr[u][i][0] * xr[u][i][0] + xr[u][i][1] * xr[u][i][1] + xr[u][i][2] * xr[u][i][2] + xr[u][i][3] * xr[u][i][3];
            ssq = wave_sum(ssq);
            const float rstd = __builtin_amdgcn_rsqf(ssq * (1.0f / 1024.0f) + EPS);
#pragma unroll
            for (int i = 0; i < 4; ++i) *(f32x4*)(out + (size_t)(r0 + u) * D + i * 256 + lane * 4) = xr[u][i] * rstd * gf[i]; }
    }
}

#define XB_TMO      128
#define XB_XCNT(j)  (256  + 64 * (j))
#define XB_XSUB(j)  (1280 + 64 * (j))
#define XB_XGEN(j)  (2304 + 64 * (j))
#define XB_TOP      3328
#define XB_TOPGEN   3392
#define XCD_BAR_WORDS 3456
#define XB_SPIN_CAP (1u << 18)
__device__ __forceinline__ unsigned xb_ld(unsigned* p)              { return __hip_atomic_load(p, __ATOMIC_RELAXED, __HIP_MEMORY_SCOPE_AGENT); }
__device__ __forceinline__ unsigned xb_add(unsigned* p, unsigned v) { return __hip_atomic_fetch_add(p, v, __ATOMIC_RELAXED, __HIP_MEMORY_SCOPE_AGENT); }
__device__ __forceinline__ unsigned xb_xcc_id() { return (unsigned)__builtin_amdgcn_s_getreg((3 << 11) | 20) & 0xFu; }
#define XB_SPIN(cond, bar) do { unsigned _sp = 0; while (cond) { __builtin_amdgcn_s_sleep(1); \
    if ((++_sp & 255u) == 0u) { if (xb_ld(&(bar)[XB_TMO])) break; if (_sp > XB_SPIN_CAP) { atomicAdd(&(bar)[XB_TMO], 1u); break; } } } } while (0)
struct XcdBarrier { unsigned* bar; unsigned x; volatile LAS unsigned* st; };
__device__ __forceinline__ void xcd_barrier_complete(unsigned* bar, unsigned x, unsigned& nloc, unsigned& nx) {
    const unsigned G = gridDim.x * gridDim.y * gridDim.z;
    unsigned sum, cnt, mine, sp = 0u;
    for (;;) {
        sum = 0u; cnt = 0u; mine = 0u;
#pragma unroll
        for (unsigned j = 0; j < 16; ++j) { const unsigned c = xb_ld(&bar[XB_XCNT(j)]); sum += c; cnt += (c > 0u) ? 1u : 0u; mine = (j == x) ? c : mine; }
        if (sum == G) break;
        __builtin_amdgcn_s_sleep(1);
        if ((++sp & 255u) == 0u) { if (xb_ld(&bar[XB_TMO])) break; if (sp > XB_SPIN_CAP) { atomicAdd(&bar[XB_TMO], 1u); break; } }
    }
    nloc = mine > 0u ? mine : 1u; nx = cnt > 0u ? cnt : 1u;
}
__device__ __forceinline__ void xcd_barrier(const XcdBarrier& b, bool leader_thread) {
    asm volatile("s_waitcnt vmcnt(0)" ::: "memory");
    __syncthreads();
    if (leader_thread) {
        unsigned* bar = b.bar;
        __builtin_amdgcn_s_waitcnt(0);
        unsigned nloc = b.st[0], nx = b.st[1];
        if (nloc == 0u) { xcd_barrier_complete(bar, b.x, nloc, nx); b.st[0] = nloc; b.st[1] = nx; }
        const unsigned old = xb_add(&bar[XB_XSUB(b.x)], 1u);
        const unsigned gen = old / nloc;
        if (old + 1u == (gen + 1u) * nloc) {
            __builtin_amdgcn_fence(__ATOMIC_RELEASE, "agent");
            asm volatile("s_waitcnt vmcnt(0)" ::: "memory");
            const unsigned og = xb_add(&bar[XB_TOP], 1u);
            const unsigned tg = og / nx;
            if (og + 1u == (tg + 1u) * nx) xb_add(&bar[XB_TOPGEN], 1u);
            else XB_SPIN(xb_ld(&bar[XB_TOPGEN]) == tg, bar);
            __builtin_amdgcn_fence(__ATOMIC_ACQUIRE, "agent");
            xb_add(&bar[XB_XGEN(b.x)], 1u);
            asm volatile("s_waitcnt vmcnt(0)" ::: "memory");
        } else {
            XB_SPIN(xb_ld(&bar[XB_XGEN(b.x)]) == gen, bar);
            __builtin_amdgcn_fence(__ATOMIC_ACQUIRE, "agent");
            asm volatile("s_waitcnt vmcnt(0)" ::: "memory");
        }
    }
    __syncthreads();
}

__global__ void __launch_bounds__(512, 2) mega_fwd(Args a) {
    extern __shared__ __attribute__((aligned(16))) unsigned char shm[];
    cg::grid_group grid = cg::this_grid();
    LAS unsigned char* lds = (LAS unsigned char*)shm;
    unsigned char* ws = a.ws;
    bf16_t* IN0T = (bf16_t*)(ws + WS_IN0T); bf16_t* OUT0T = (bf16_t*)(ws + WS_OUT0T); bf16_t* IN1T = (bf16_t*)(ws + WS_IN1T); bf16_t* OUT1T = (bf16_t*)(ws + WS_OUT1T);
    bf16_t* POOLT = (bf16_t*)(ws + WS_POOLT); float* SGUW = (float*)(ws + WS_SGUW); float* ADA = (float*)(ws + WS_ADA); float* GLR = (float*)(ws + WS_GLR); float* SSQ = (float*)(ws + WS_SSQ);
    bf16_t* H = (bf16_t*)(ws + WS_H); bf16_t* AU = (bf16_t*)(ws + WS_BUFA); bf16_t* Y0 = AU + (size_t)M * 2048; bf16_t* QK = AU;
    bf16_t* V0 = (bf16_t*)(ws + WS_BUFV); bf16_t* P = V0 + (size_t)M * 1024; bf16_t* V1 = V0;
    const int G = gridDim.x, c = blockIdx.x;
    const int wv = __builtin_amdgcn_readfirstlane(threadIdx.x >> 6);
    volatile LAS unsigned* xbst = (volatile LAS unsigned*)(lds + 131072);
    if (threadIdx.x == 0) { xbst[0] = 0u; xbst[1] = 0u; }
    __syncthreads();
    XcdBarrier xbar; xbar.bar = (unsigned*)(ws + WS_BAR); xbar.x = xb_xcc_id(); xbar.st = xbst;
    if (a.ph_hi - a.ph_lo > 1 && threadIdx.x == 0) (void)xb_add(&xbar.bar[XB_XCNT(xbar.x)], 1u);
    if (a.ph_lo < 0) grid.sync();
    for (int ph = a.ph_lo; ph < a.ph_hi; ++ph) {
        switch (ph) {
        case 0: phase_prep(wv, a, (LAS float*)lds); break;
        case 1: phase_h(wv, a.in[I_X], a.in[I_NORMG], ADA, H, false, nullptr, nullptr, (LAS float*)lds); break;
        case 2: {
            { pg8::Gemm g{H, H, IN0T}; pg8::StaticOrder S; S.init(M, 2048, G, c); pg8::EpiRow<0> E{AU, 2048, nullptr, nullptr};
              pg8::gemm_phase<pg8::EpiRow<0>, pg8::StaticOrder, true, 1024, 1024, 16>(wv, lds, g, S, E); }
            { pg8::Gemm g{H, H, IN0T + (size_t)2048 * 1024}; pg8::StaticOrder S; S.init(M, 1024, G, c); pg8::EpiVBlk E{V0, 1024};
              pg8::gemm_phase<pg8::EpiVBlk, pg8::StaticOrder, false, 1024, 1024, 16>(wv, lds, g, S, E); }
            { pg8::Gemm g{H, H, IN0T + (size_t)3072 * 1024}; pg8::StaticOrder S; S.init(M, 2048, G, c); pg8::EpiRow<1> E{Y0, 2048, nullptr, nullptr};
              pg8::gemm_phase<pg8::EpiRow<1>, pg8::StaticOrder, true, 1024, 1024, 16>(wv, lds, g, S, E); }
        } break;
        case 3: phase_poolp(wv, AU, P); phase_sgu(wv, AU, V0, Y0, SGUW, a.in[I_SGUB], a.in[I_SGUG], (LAS float*)lds); break;
        case 4: { asm volatile("s_waitcnt vmcnt(0)" ::: "memory"); __syncthreads();
              pg8::Gemm g{P, P, POOLT}; pg8::PoolOrder S{G, c}; pg8::EpiRow<2> E{Y0, 2048, nullptr, nullptr};
              pg8::gemm_phase<pg8::EpiRow<2>, pg8::PoolOrder, true, 256, 1024, 4>(wv, lds, g, S, E); } break;
        case 5: { pg8::Gemm g{Y0, Y0, OUT0T}; pg8::StaticOrder S; S.init(M, 1024, G, c); pg8::EpiOut E{a.in[I_X], a.out, ADA + 2048};
              pg8::gemm_phase<pg8::EpiOut, pg8::StaticOrder, true, 2048, 2048, 32>(wv, lds, g, S, E); } break;
        case 6: phase_h(wv, a.out, a.in[I_NORMG] + 1024, ADA + 16 * 3072, H, true, a.in[I_OINW], GLR, (LAS float*)lds); break;
        case 7: {
            { pg8::Gemm g{H, H, IN1T}; pg8::StaticOrder S; S.init(M, 3072, G, c); pg8::EpiRow<0> E{QK, 4096, nullptr, nullptr};
              pg8::gemm_phase<pg8::EpiRow<0>, pg8::StaticOrder, true, 1024, 1024, 16>(wv, lds, g, S, E); }
            { pg8::Gemm g{H, H, IN1T + (size_t)3072 * 1024}; pg8::StaticOrder S; S.init(M, 2048, G, c); pg8::EpiVBlk E{V1, 2048};
              pg8::gemm_phase<pg8::EpiVBlk, pg8::StaticOrder, false, 1024, 1024, 16>(wv, lds, g, S, E); }
        } break;
        case 8: phase_glapre(wv, QK, GLR, (float*)(ws + WS_EB), a.in[I_GGW], a.in[I_GGB], lds); phase_sb(wv, QK, V1, lds); break;
        case 9: phase_gla2(wv, QK, V1, QK + 3072, (const float*)(ws + WS_EB), SSQ, lds); break;
        case 10: { pg8::Gemm g{H, H, IN1T + (size_t)5120 * 1024}; pg8::StaticOrder S; S.init(M, 2048, G, c); pg8::EpiRow<3> E{QK, 4096, SSQ, a.in[I_GNG]};
              pg8::gemm_phase<pg8::EpiRow<3>, pg8::StaticOrder, true, 1024, 1024, 16>(wv, lds, g, S, E); } break;
        case 11: { pg8::Gemm g{QK + 3072, QK + 1024, OUT1T}; pg8::StaticOrder S; S.init(M, 1024, G, c); pg8::EpiOut E{a.out, a.out, ADA + 16 * 3072 + 2048};
              pg8::gemm_phase<pg8::EpiOut, pg8::StaticOrder, true, 2048, 4096, 16>(wv, lds, g, S, E); } break;
        case 12: phase_final(wv, a.out, a.in[I_FG]); break;
        }
        if (ph + 1 < a.ph_hi && ph != 3) xcd_barrier(xbar, opaque_tid(wv) == 0);
    }
}

extern "C" void kernel_launch(void* const* d_in, const int* in_sizes, int n_in, void* d_out, int out_size, void* d_ws, size_t ws_size, hipStream_t stream) {
    static int grid = 0;
    if (grid == 0) {
        if (n_in != 18 || out_size != M * D || ws_size < WS_END) { fprintf(stderr, "kernel_launch: unexpected shapes (n_in %d out %d ws %zu need %zu)\n", n_in, out_size, ws_size, (size_t)WS_END); grid = -1; return; }
        int dev = 0, cus = 0, per_cu = 0;
        hipGetDevice(&dev); hipDeviceGetAttribute(&cus, hipDeviceAttributeMultiprocessorCount, dev);
        if (hipFuncSetAttribute((const void*)mega_fwd, hipFuncAttributeMaxDynamicSharedMemorySize, LDS_BYTES) != hipSuccess) { fprintf(stderr, "kernel_launch: hipFuncSetAttribute failed\n"); grid = -1; return; }
        if (hipOccupancyMaxActiveBlocksPerMultiprocessor(&per_cu, (const void*)mega_fwd, 512, LDS_BYTES) != hipSuccess || per_cu < 1) { fprintf(stderr, "kernel_launch: occupancy query says %d blocks/CU\n", per_cu); per_cu = 1; }
        (void)hipGetLastError();
        grid = cus;
    }
    if (grid < 0) return;
    Args a{};
    for (int i = 0; i < 18; ++i) a.in[i] = (const float*)d_in[i];
    a.out = (float*)d_out; a.ws = (unsigned char*)d_ws;
#if N_LAUNCH_MODE == 1
    a.ph_lo = 0; a.ph_hi = NPHASE;
    (void)hipMemsetAsync((unsigned char*)d_ws + WS_BAR, 0, 16384, stream);
    void* args[] = {&a};
    hipError_t e = hipLaunchCooperativeKernel((const void*)mega_fwd, dim3(grid), dim3(512), args, LDS_BYTES, stream);
    if (e != hipSuccess) fprintf(stderr, "cooperative launch failed: %s (grid %d)\n", hipGetErrorString(e), grid);
#else
    for (int ph = 0; ph < NPHASE; ++ph) { a.ph_lo = ph; a.ph_hi = ph + 1; hipLaunchKernelGGL(mega_fwd, dim3(grid), dim3(512), LDS_BYTES, stream, a); }
#endif
}
```

```cpp
#include <hip/hip_runtime.h>
#include <hip/hip_cooperative_groups.h>
#include <cstdio>
namespace cg = cooperative_groups;

#ifndef N_LAUNCH_MODE
#define N_LAUNCH_MODE 1
#endif

#define LAS __attribute__((address_space(3)))
typedef unsigned short bf16_t;
typedef short bf16x8 __attribute__((ext_vector_type(8)));
typedef float f32x4 __attribute__((ext_vector_type(4)));
typedef unsigned u32x4 __attribute__((ext_vector_type(4)));
typedef unsigned u32x2 __attribute__((ext_vector_type(2)));

constexpr int NB = 16, SEQ = 2048, D = 1024, M = NB * SEQ;
constexpr float EPS = 1e-6f;
constexpr int LDS_BYTES = 131072 + 16;
constexpr int NPHASE = 13;

constexpr size_t WS_BAR = 0;
constexpr size_t WS_IN0T = 16384;
constexpr size_t WS_OUT0T = WS_IN0T + 5120ull * 1024 * 2;
constexpr size_t WS_IN1T = WS_OUT0T + 1024ull * 2048 * 2;
constexpr size_t WS_OUT1T = WS_IN1T + 7168ull * 1024 * 2;
constexpr size_t WS_POOLT = WS_OUT1T + 1024ull * 2048 * 2;
constexpr size_t WS_SGUW = WS_POOLT + 1024ull * 256 * 2;
constexpr size_t WS_ADA = WS_SGUW + 8ull * 128 * 128 * 4;
constexpr size_t WS_GLR = WS_ADA + 2ull * 16 * 3072 * 4;
constexpr size_t WS_SSQ = WS_GLR + (size_t)M * 16 * 4;
constexpr size_t WS_H = WS_SSQ + (size_t)M * 32 * 4;
constexpr size_t WS_BUFA = WS_H + (size_t)M * 1024 * 2;
constexpr size_t WS_BUFV = WS_BUFA + (size_t)M * 4096 * 2;
constexpr size_t WS_EB = WS_BUFV + (size_t)M * 2048 * 2;
constexpr size_t WS_END = WS_EB + 2048ull * 128 * 4;

typedef float f32x2 __attribute__((ext_vector_type(2)));
typedef __bf16 bf16x2_t __attribute__((ext_vector_type(2)));
__device__ __forceinline__ unsigned cvt_pk_bf16(float lo, float hi) { const f32x2 v = {lo, hi}; return __builtin_bit_cast(unsigned, __builtin_convertvector(v, bf16x2_t)); }
__device__ __forceinline__ unsigned cvt_pk_bf16_asm(float lo, float hi) { unsigned r; asm("v_cvt_pk_bf16_f32 %0, %1, %2" : "=v"(r) : "v"(lo), "v"(hi)); return r; }
__device__ __forceinline__ float bf2f(bf16_t b) { return __uint_as_float(((unsigned)b) << 16); }
__device__ __forceinline__ float bflo(unsigned u) { return __uint_as_float(u << 16); }
__device__ __forceinline__ float bfhi(unsigned u) { return __uint_as_float(u & 0xffff0000u); }
__device__ __forceinline__ bf16_t f2bf(float f) { return (bf16_t)(cvt_pk_bf16(f, 0.f) & 0xffffu); }
__device__ __forceinline__ float silu_f(float x) { return x * __builtin_amdgcn_rcpf(1.0f + __builtin_amdgcn_exp2f(-1.4426950408889634f * x)); }
__device__ __forceinline__ float logsig2_f(float z2) { return fminf(z2, 0.f) - __builtin_amdgcn_logf(1.0f + __builtin_amdgcn_exp2f(-fabsf(z2))); }
__device__ __forceinline__ int vslot(int x) { return ((x >> 2) & 3) * 8 + ((x >> 4) & 1) * 4 + (x & 3); }
__device__ __forceinline__ float wave_sum(float v) {
#pragma unroll
    for (int m = 32; m >= 1; m >>= 1) v += __shfl_xor(v, m);
    return v;
}
__device__ __forceinline__ bf16x8 pack8(f32x4 a, f32x4 b) {
    u32x4 w; w.x = cvt_pk_bf16(a[0], a[1]); w.y = cvt_pk_bf16(a[2], a[3]); w.z = cvt_pk_bf16(b[0], b[1]); w.w = cvt_pk_bf16(b[2], b[3]);
    return __builtin_bit_cast(bf16x8, w);
}
__device__ __forceinline__ int opaque_tid(int wv) { int t = (wv << 6) | (int)__builtin_amdgcn_mbcnt_hi(~0u, __builtin_amdgcn_mbcnt_lo(~0u, 0u)); asm volatile("" : "+v"(t)); return t; }
#define MFMA16(a, b, c) __builtin_amdgcn_mfma_f32_16x16x32_bf16((a), (b), (c), 0, 0, 0)

namespace pg8 {
constexpr int BM = 256, BK = 64, HALF = 128, HTB = HALF * BK * 2, STAGE_BYTES = 8 * HTB, NXCD = 8, WGM = 8;
__host__ __device__ __forceinline__ int lds_byte(int r, int c) { const int st = (r >> 4) * 2 + (c >> 5), rr = r & 15, cc = c & 31, ob = rr * 64 + cc * 2; return st * 1024 + (ob ^ (((ob >> 9) & 1) << 5)); }
__host__ __device__ __forceinline__ void stage_rc(int b, int& R, int& C) { const int st = b / 1024, sb = b % 1024, swz = sb ^ (((sb >> 9) & 1) << 5); R = (st >> 1) * 16 + swz / 64; C = (st & 1) * 32 + (swz % 64) / 2; }
__host__ __device__ __forceinline__ int perm32(int rho) { const int n = rho >> 4, i = rho & 15; return 8 * (i >> 2) + 4 * n + (i & 3); }

struct Unit { int pm, pn; unsigned aoff; };
struct Gemm { const bf16_t* A; const bf16_t* A1; const bf16_t* Bt; };

struct StaticOrder {
    int nM, nN, nwg, G, c;
    __device__ void init(int M_, int N_, int G_, int c_) { nM = M_ / BM; nN = N_ / BM; nwg = nM * nN; G = G_; c = c_; }
    __device__ bool next(int i, Unit& u) const {
        const long L = (long)i * G + c; if (L >= nwg) return false;
        int wgid = (int)L; { const int q = nwg / NXCD, r = nwg % NXCD, xcd = wgid % NXCD, off = wgid / NXCD; wgid = (xcd < r ? xcd * (q + 1) : r * (q + 1) + (xcd - r) * q) + off; }
        const int nig = WGM * nN, gid = wgid / nig, fm = gid * WGM, gsz = (nM - fm) < WGM ? (nM - fm) : WGM;
        u.pm = fm + ((wgid % nig) % gsz); u.pn = (wgid % nig) / gsz; u.aoff = 0; return true;
    }
};
struct PoolOrder {
    int G, c;
    __device__ bool next(int i, Unit& u) const {
        const int L = i * G + c; if (L >= 512) return false;
        u.pm = L >> 2; u.pn = L & 3; u.aoff = (unsigned)(u.pn * 256 * 2); return true;
    }
};

template <class Epi, class Sched, bool SWAP, int K, int lda, int ksplit>
__device__ __forceinline__ void gemm_phase(int wv, LAS unsigned char* lds, const Gemm g, const Sched& S, const Epi& E) {
    const int tid = opaque_tid(wv), wid = __builtin_amdgcn_readfirstlane(tid >> 6), lane = tid & 63, wr = wid >> 2, wc = wid & 3, fr = lane & 15, fq = lane >> 4;
    constexpr int nt = K / BK;
    unsigned voffA[2], voffB[2];
#pragma unroll
    for (int i = 0; i < 2; ++i) { int R, C; stage_rc(tid * 16 + i * 8192, R, C); const int Rb = Epi::PERM ? ((R & ~31) + perm32(R & 31)) : R;
        voffA[i] = (unsigned)(R * lda + C) * 2u; voffB[i] = (unsigned)(Rb * K + C) * 2u; }
    const size_t kstep = (size_t)(BK * 2);
    const size_t hstepA = (size_t)HALF * lda * 2, hstepB = (size_t)HALF * K * 2;
    const size_t tstepA = 2 * hstepA, tstepB = 2 * hstepB;
    const unsigned ldsw = (unsigned)wid * 1024u;
    const int aoff = lds_byte(wr * 64 + fr, fq * 8), boff = lds_byte(wc * 32 + fr, fq * 8);
#define PG8_SA(b, h) (((b) * 2 + (h)) * HTB)
#define PG8_SB(b, h) ((4 + (b) * 2 + (h)) * HTB)
#define PG8_STAGE(bufoff, gbase, voff) do { _Pragma("unroll") for (int _i = 0; _i < 2; ++_i) \
        __builtin_amdgcn_global_load_lds((const unsigned*)((const char*)(gbase) + (voff)[_i]), (LAS unsigned*)(lds + (bufoff) + ldsw + _i * 8192), 16, 0, 0); } while (0)
#define PG8_LDA(dst, b, h) do { _Pragma("unroll") for (int m = 0; m < 4; ++m) _Pragma("unroll") for (int k = 0; k < 2; ++k) dst[m][k] = *(const LAS bf16x8*)(lds + PG8_SA(b, h) + aoff + m * 2048 + k * 1024); } while (0)
#define PG8_LDB(dst, b, h) do { _Pragma("unroll") for (int n = 0; n < 2; ++n) _Pragma("unroll") for (int k = 0; k < 2; ++k) dst[n][k] = *(const LAS bf16x8*)(lds + PG8_SB(b, h) + boff + n * 2048 + k * 1024); } while (0)
#define PG8_MMA(ai, bj, At, Bt) do { __builtin_amdgcn_s_setprio(1); _Pragma("unroll") for (int m = 0; m < 4; ++m) _Pragma("unroll") for (int n = 0; n < 2; ++n) _Pragma("unroll") for (int k = 0; k < 2; ++k) \
        acc[ai][bj][m][n] = SWAP ? __builtin_amdgcn_mfma_f32_16x16x32_bf16(Bt[n][k], At[m][k], acc[ai][bj][m][n], 0, 0, 0) \
                                 : __builtin_amdgcn_mfma_f32_16x16x32_bf16(At[m][k], Bt[n][k], acc[ai][bj][m][n], 0, 0, 0); __builtin_amdgcn_s_setprio(0); } while (0)
#define PG8_WAIT_V(n) asm volatile("s_waitcnt vmcnt(" #n ")" ::: "memory")
#define PG8_WAIT_L(n) asm volatile("s_waitcnt lgkmcnt(" #n ")" ::: "memory")
#define PG8_BAR __builtin_amdgcn_s_barrier()
#define PG8_SCHED __builtin_amdgcn_sched_barrier(0)
#define PG8_APTR(p0, p1, tt) ((ksplit >= nt || (tt) < ksplit) ? (p0) + (size_t)(tt) * kstep : (p1) + (size_t)((tt) - ksplit) * kstep)
    Unit cur, nxt; int ui = 0;
    if (!S.next(0, cur)) return;
    f32x4 acc[2][2][4][2];
#pragma unroll
    for (int a = 0; a < 2; ++a)
#pragma unroll
        for (int b = 0; b < 2; ++b)
#pragma unroll
            for (int m = 0; m < 4; ++m)
#pragma unroll
                for (int n = 0; n < 2; ++n) acc[a][b][m][n] = (f32x4){0.f, 0.f, 0.f, 0.f};
    bf16x8 At[4][2], B0[2][2], B1[2][2];
    const char* cA = (const char*)g.A + (size_t)cur.pm * tstepA + cur.aoff; const char* cA1 = (const char*)g.A1 + (size_t)cur.pm * tstepA;
    const char* cB = (const char*)g.Bt + (size_t)cur.pn * tstepB;
    PG8_STAGE(PG8_SB(0, 0), cB, voffB); PG8_STAGE(PG8_SB(0, 1), cB + hstepB, voffB); PG8_STAGE(PG8_SA(0, 0), cA, voffA); PG8_STAGE(PG8_SA(0, 1), cA + hstepA, voffA);
    if (wr == 1) PG8_BAR;
    PG8_WAIT_V(2); PG8_BAR;
    PG8_STAGE(PG8_SB(1, 0), cB + kstep, voffB); PG8_STAGE(PG8_SA(1, 0), cA + kstep, voffA); PG8_STAGE(PG8_SB(1, 1), cB + hstepB + kstep, voffB);
    PG8_WAIT_V(6); PG8_BAR;
    for (;;) {
        const bool has_next = S.next(ui + 1, nxt);
        const char* nA = has_next ? (const char*)g.A + (size_t)nxt.pm * tstepA + nxt.aoff : cA; const char* nA1 = has_next ? (const char*)g.A1 + (size_t)nxt.pm * tstepA : cA1;
        const char* nB = has_next ? (const char*)g.Bt + (size_t)nxt.pn * tstepB : cB;
#pragma unroll 1
        for (int t = 0; t < nt; t += 2) {
            const bool last = (t == nt - 2);
            const char* a1 = PG8_APTR(cA, cA1, t + 1);
            const char* a2 = last ? nA : PG8_APTR(cA, cA1, t + 2); const char* b2 = last ? nB : cB + (size_t)(t + 2) * kstep;
            const char* a3 = last ? nA + kstep : PG8_APTR(cA, cA1, t + 3); const char* b3 = b2 + kstep;
            PG8_LDB(B0, 0, 0); PG8_LDB(B1, 0, 1); PG8_SCHED; PG8_LDA(At, 0, 0); PG8_STAGE(PG8_SA(1, 1), a1 + hstepA, voffA);
            PG8_WAIT_V(8); PG8_WAIT_L(0); PG8_BAR; PG8_MMA(0, 0, At, B0); PG8_MMA(0, 1, At, B1); PG8_BAR; PG8_SCHED;
            PG8_LDA(At, 0, 1); PG8_STAGE(PG8_SB(0, 0), b2, voffB); PG8_STAGE(PG8_SB(0, 1), b2 + hstepB, voffB); PG8_STAGE(PG8_SA(0, 0), a2, voffA);
            PG8_WAIT_V(8); PG8_WAIT_L(0); PG8_BAR; PG8_MMA(1, 0, At, B0); PG8_MMA(1, 1, At, B1); PG8_BAR; PG8_SCHED;
            PG8_LDB(B0, 1, 0); PG8_LDB(B1, 1, 1); PG8_SCHED; PG8_LDA(At, 1, 0); PG8_STAGE(PG8_SA(0, 1), a2 + hstepA, voffA);
            PG8_WAIT_V(8); PG8_WAIT_L(0); PG8_BAR; PG8_MMA(0, 0, At, B0); PG8_MMA(0, 1, At, B1); PG8_BAR; PG8_SCHED;
            PG8_LDA(At, 1, 1); PG8_STAGE(PG8_SB(1, 0), b3, voffB); PG8_STAGE(PG8_SB(1, 1), b3 + hstepB, voffB); PG8_STAGE(PG8_SA(1, 0), a3, voffA);
            PG8_WAIT_V(8); PG8_WAIT_L(0); PG8_BAR; PG8_MMA(1, 0, At, B0); PG8_MMA(1, 1, At, B1); PG8_BAR; PG8_SCHED;
        }
        if (wr == 0) PG8_BAR;
        E(acc, cur, wr, wc, fr, fq);
        if (!has_next) break;
#pragma unroll
        for (int a = 0; a < 2; ++a)
#pragma unroll
            for (int b = 0; b < 2; ++b)
#pragma unroll
                for (int m = 0; m < 4; ++m)
#pragma unroll
                    for (int n = 0; n < 2; ++n) acc[a][b][m][n] = (f32x4){0.f, 0.f, 0.f, 0.f};
        cur = nxt; cA = nA; cA1 = nA1; cB = nB; ++ui;
        if (wr == 1) PG8_BAR;
    }
    PG8_WAIT_V(0);
    PG8_BAR;
#undef PG8_SA
#undef PG8_SB
#undef PG8_STAGE
#undef PG8_LDA
#undef PG8_LDB
#undef PG8_MMA
#undef PG8_WAIT_V
#undef PG8_WAIT_L
#undef PG8_BAR
#undef PG8_SCHED
#undef PG8_APTR
}

template <int MODE> struct EpiRow {
    static constexpr bool PERM = true;
    bf16_t* O; int ldc; const float* ssq; const float* gn;
    __device__ __forceinline__ void operator()(const f32x4 (&acc)[2][2][4][2], const Unit& u, int wr, int wc, int fr, int fq) const {
        const int row0 = u.pm * BM + wr * 64 + fr; const int colt = u.pn * BM;
        int dcol = colt;
        if (MODE == 3) dcol = (colt < 1024) ? 3072 + colt : colt;
        const bool ycpart = (MODE == 3) && (colt < 1024);
        f32x4 gg[2][2];
        if (MODE == 3) {
#pragma unroll
            for (int bj = 0; bj < 2; ++bj) { const int cy = (ycpart ? colt : 0) + bj * HALF + wc * 32 + 8 * fq; gg[bj][0] = *(const f32x4*)(gn + cy); gg[bj][1] = *(const f32x4*)(gn + cy + 4); } }
#pragma unroll
        for (int ai = 0; ai < 2; ++ai)
#pragma unroll
            for (int mh = 0; mh < 2; ++mh) {
                u32x4 old[2][2]; f32x4 sq[2][2];
                if (MODE == 2 || MODE == 3) {
#pragma unroll
                    for (int m2 = 0; m2 < 2; ++m2) { const int row = row0 + ai * HALF + (2 * mh + m2) * 16;
#pragma unroll
                        for (int bj = 0; bj < 2; ++bj) old[m2][bj] = *(const u32x4*)(O + (size_t)row * ldc + dcol + bj * HALF + wc * 32 + 8 * fq);
                        if (MODE == 3) { const int head = ycpart ? (colt >> 8) : 0;
                            sq[m2][0] = *(const f32x4*)(ssq + ((size_t)row * 4 + head) * 8); sq[m2][1] = *(const f32x4*)(ssq + ((size_t)row * 4 + head) * 8 + 4); } }
                    __builtin_amdgcn_sched_barrier(0); }
#pragma unroll
                for (int m2 = 0; m2 < 2; ++m2) { const int m = 2 * mh + m2; const int row = row0 + ai * HALF + m * 16;
                    float rstd = 1.0f;
                    if (MODE == 3) rstd = __builtin_amdgcn_rsqf((sq[m2][0][0] + sq[m2][0][1] + sq[m2][0][2] + sq[m2][0][3] + sq[m2][1][0] + sq[m2][1][1] + sq[m2][1][2] + sq[m2][1][3]) * (1.0f / 256.0f) + EPS);
#pragma unroll
                    for (int bj = 0; bj < 2; ++bj) {
                        const int cin = bj * HALF + wc * 32 + 8 * fq;
                        bf16_t* p = O + (size_t)row * ldc + dcol + cin;
                        f32x4 v0 = acc[ai][bj][m][0], v1 = acc[ai][bj][m][1];
                        if (MODE == 1) {
#pragma unroll
                            for (int j = 0; j < 4; ++j) { v0[j] = silu_f(v0[j]); v1[j] = silu_f(v1[j]); } }
                        if (MODE == 2) { const u32x4 o = old[m2][bj];
                            v0[0] *= bflo(o.x); v0[1] *= bfhi(o.x); v0[2] *= bflo(o.y); v0[3] *= bfhi(o.y); v1[0] *= bflo(o.z); v1[1] *= bfhi(o.z); v1[2] *= bflo(o.w); v1[3] *= bfhi(o.w); }
                        if (MODE == 3) { const u32x4 o = old[m2][bj];
                            float y[8] = {bflo(o.x), bfhi(o.x), bflo(o.y), bfhi(o.y), bflo(o.z), bfhi(o.z), bflo(o.w), bfhi(o.w)};
                            if (ycpart) {
#pragma unroll
                                for (int j = 0; j < 4; ++j) { y[j] *= rstd * gg[bj][0][j]; y[4 + j] *= rstd * gg[bj][1][j]; } }
#pragma unroll
                            for (int j = 0; j < 4; ++j) { v0[j] = silu_f(v0[j]) * y[j]; v1[j] = silu_f(v1[j]) * y[4 + j]; } }
                        u32x4 w; w.x = cvt_pk_bf16_asm(v0[0], v0[1]); w.y = cvt_pk_bf16_asm(v0[2], v0[3]); w.z = cvt_pk_bf16_asm(v1[0], v1[1]); w.w = cvt_pk_bf16_asm(v1[2], v1[3]);
                        *(u32x4*)p = w; } }
                if (MODE == 2 || MODE == 3) __builtin_amdgcn_sched_barrier(0); }
    }
};
struct EpiVBlk {
    static constexpr bool PERM = false;
    bf16_t* O; int NC;
    __device__ __forceinline__ void operator()(const f32x4 (&acc)[2][2][4][2], const Unit& u, int wr, int wc, int fr, int fq) const {
#pragma unroll
        for (int ai = 0; ai < 2; ++ai)
#pragma unroll
            for (int bj = 0; bj < 2; ++bj)
#pragma unroll
                for (int n = 0; n < 2; ++n) { const int C = u.pn * BM + bj * HALF + wc * 32 + n * 16 + fr;
#pragma unroll
                    for (int i = 0; i < 2; ++i) { const int grp = u.pm * 8 + ai * 4 + wr * 2 + i;
                        const f32x4 v0 = acc[ai][bj][2 * i][n], v1 = acc[ai][bj][2 * i + 1][n];
                        u32x4 w; w.x = cvt_pk_bf16_asm(v0[0], v0[1]); w.y = cvt_pk_bf16_asm(v0[2], v0[3]); w.z = cvt_pk_bf16_asm(v1[0], v1[1]); w.w = cvt_pk_bf16_asm(v1[2], v1[3]);
                        *(u32x4*)(O + ((size_t)grp * NC + C) * 32 + fq * 8) = w; } }
    }
};
struct EpiOut {
    static constexpr bool PERM = true;
    const float* resid; float* out; const float* gate;
    __device__ __forceinline__ void operator()(const f32x4 (&acc)[2][2][4][2], const Unit& u, int wr, int wc, int fr, int fq) const {
        const int row0 = u.pm * BM + wr * 64 + fr, col0 = u.pn * BM + wc * 32 + 8 * fq;
        const int b = (u.pm * BM) >> 11;
        f32x4 gv[2][2];
#pragma unroll
        for (int bj = 0; bj < 2; ++bj)
#pragma unroll
            for (int n = 0; n < 2; ++n) gv[bj][n] = *(const f32x4*)(gate + (size_t)b * 3072 + col0 + bj * HALF + n * 4);
#pragma unroll
        for (int ai = 0; ai < 2; ++ai)
#pragma unroll
            for (int mh = 0; mh < 2; ++mh) { f32x4 r[2][2][2];
#pragma unroll
                for (int m2 = 0; m2 < 2; ++m2) { const size_t ro = (size_t)(row0 + ai * HALF + (2 * mh + m2) * 16) * D + col0;
#pragma unroll
                    for (int bj = 0; bj < 2; ++bj)
#pragma unroll
                        for (int n = 0; n < 2; ++n) r[m2][bj][n] = *(const f32x4*)(resid + ro + bj * HALF + n * 4); }
                __builtin_amdgcn_sched_barrier(0);
#pragma unroll
                for (int m2 = 0; m2 < 2; ++m2) { const size_t ro = (size_t)(row0 + ai * HALF + (2 * mh + m2) * 16) * D + col0;
#pragma unroll
                    for (int bj = 0; bj < 2; ++bj)
#pragma unroll
                        for (int n = 0; n < 2; ++n) *(f32x4*)(out + ro + bj * HALF + n * 4) = r[m2][bj][n] + gv[bj][n] * acc[ai][bj][2 * mh + m2][n]; }
                __builtin_amdgcn_sched_barrier(0); }
    }
};
}

struct Args { const float* in[18]; float* out; unsigned char* ws; int ph_lo, ph_hi; };
enum { I_X = 0, I_C, I_ADAW, I_ADAB, I_NORMG, I_EINW, I_POOLW, I_POOLS, I_SGUG, I_SGUW, I_SGUB, I_EOUTW, I_OINW, I_GGW, I_GGB, I_GNG, I_OOUTW, I_FG };

__device__ __forceinline__ void transpose_tile(int wv, LAS float* tile, const float* src, int ld, int col0, int k0, bf16_t* dst, int ldd, int row0, const float* scale) {
    const int tid = opaque_tid(wv);
    { const int r = tid >> 4, c4 = tid & 15; f32x4 v[4];
#pragma unroll
      for (int i = 0; i < 4; ++i) v[i] = *(const f32x4*)(src + (size_t)(k0 + r + 32 * i) * ld + col0 + c4 * 4);
#pragma unroll
      for (int i = 0; i < 4; ++i)
#pragma unroll
          for (int j = 0; j < 4; ++j) tile[(r + 32 * i) * 65 + c4 * 4 + j] = v[i][j]; }
    __syncthreads();
    { const int n = tid >> 3, kc = (tid & 7) * 16; const float s = scale ? scale[n] : 1.0f;
#pragma unroll
      for (int h = 0; h < 2; ++h) { f32x4 a, b;
#pragma unroll
          for (int j = 0; j < 4; ++j) { a[j] = tile[(kc + 8 * h + j) * 65 + n] * s; b[j] = tile[(kc + 8 * h + 4 + j) * 65 + n] * s; }
          *(bf16x8*)(dst + (size_t)(row0 + n) * ldd + k0 + kc + 8 * h) = pack8(a, b); } }
    __syncthreads();
}

__device__ void phase_prep(int wv, const Args& a, LAS float* lds) {
    const int tid = opaque_tid(wv); unsigned char* ws = a.ws;
    for (int job = blockIdx.x; job < 192; job += gridDim.x) {
        {
            const int l = job / 96, cb = job % 96;
            LAS float* sc = lds; LAS float* red = lds + 16384;
            for (int i = tid; i < 16384; i += 512) sc[i] = silu_f(a.in[I_C][i]);
            __syncthreads();
            const int col = tid & 31, kg = tid >> 5;
            float acc[16];
#pragma unroll
            for (int b = 0; b < 16; ++b) acc[b] = 0.f;
            const float* w = a.in[I_ADAW] + (size_t)l * 1024 * 3072 + cb * 32 + col;
            for (int kk0 = 0; kk0 < 64; kk0 += 8) { float wv8[8];
#pragma unroll
                for (int u = 0; u < 8; ++u) wv8[u] = w[(size_t)(kg * 64 + kk0 + u) * 3072];
#pragma unroll
                for (int u = 0; u < 8; ++u) { const int k = kg * 64 + kk0 + u;
#pragma unroll
                    for (int b = 0; b < 16; ++b) acc[b] += sc[b * 1024 + k] * wv8[u]; } }
#pragma unroll
            for (int b = 0; b < 16; ++b) red[(kg * 16 + b) * 32 + col] = acc[b];
            __syncthreads();
            { const int b = tid >> 5; float s = a.in[I_ADAB][l * 3072 + cb * 32 + col];
#pragma unroll
              for (int q = 0; q < 16; ++q) s += red[(q * 16 + b) * 32 + col];
              ((float*)(ws + WS_ADA))[((size_t)l * 16 + b) * 3072 + cb * 32 + col] = s; }
            __syncthreads();
        }
    }
    struct TJob { const float* src; bf16_t* dst; const float* scale; int ld, col0, k0, ldd, row0; };
    auto decode = [&](int t) -> TJob {
        TJob j;
        if (t < 640) { const int nt = t / 8, kt = t % 8; j = TJob{a.in[I_EINW], (bf16_t*)(ws + WS_IN0T), nullptr, 5120, nt * 64, kt * 128, 1024, nt * 64}; }
        else if ((t -= 640) < 256) { const int nt = t / 16, kt = t % 16; j = TJob{a.in[I_EOUTW], (bf16_t*)(ws + WS_OUT0T), nullptr, 1024, nt * 64, kt * 128, 2048, nt * 64}; }
        else if ((t -= 256) < 896) { const int nt = t / 8, kt = t % 8; const int r0 = nt * 64;
            const int sc = r0 < 1024 ? r0 : r0 < 3072 ? 2064 + (r0 - 1024) : r0 < 4096 ? 1024 + (r0 - 3072) : r0 < 5120 ? 4112 + (r0 - 4096) : 5136 + (r0 - 5120);
            j = TJob{a.in[I_OINW], (bf16_t*)(ws + WS_IN1T), nullptr, 7184, sc, kt * 128, 1024, r0}; }
        else if ((t -= 896) < 256) { const int nt = t / 16, kt = t % 16; j = TJob{a.in[I_OOUTW], (bf16_t*)(ws + WS_OUT1T), nullptr, 1024, nt * 64, kt * 128, 2048, nt * 64}; }
        else { t -= 256; const int g = t >> 3, dt = (t >> 1) & 3, ct = t & 1;
            j = TJob{a.in[I_POOLW] + (size_t)g * 65536, (bf16_t*)(ws + WS_POOLT), a.in[I_POOLS] + g * 256 + dt * 64, 256, dt * 64, ct * 128, 256, g * 256 + dt * 64}; }
        return j; };
    {
        const int r = tid >> 4, c4 = tid & 15, n = tid >> 3, kc = (tid & 7) * 16;
        f32x4 v[4];
        int t = (int)((blockIdx.x + 64u) % gridDim.x);
        TJob cj = decode(t < 2080 ? t : 0);
        if (t < 2080) {
#pragma unroll
            for (int i = 0; i < 4; ++i) v[i] = *(const f32x4*)(cj.src + (size_t)(cj.k0 + r + 32 * i) * cj.ld + cj.col0 + c4 * 4); }
        for (; t < 2080; t += gridDim.x) {
#pragma unroll
            for (int i = 0; i < 4; ++i)
#pragma unroll
                for (int j = 0; j < 4; ++j) lds[(r + 32 * i) * 65 + c4 * 4 + j] = v[i][j];
            __syncthreads();
            const TJob pj = cj;
            const int tn = t + (int)gridDim.x;
            if (tn < 2080) { cj = decode(tn);
#pragma unroll
                for (int i = 0; i < 4; ++i) v[i] = *(const f32x4*)(cj.src + (size_t)(cj.k0 + r + 32 * i) * cj.ld + cj.col0 + c4 * 4); }
            const float s = pj.scale ? pj.scale[n] : 1.0f;
#pragma unroll
            for (int h = 0; h < 2; ++h) { f32x4 x, y;
#pragma unroll
                for (int j = 0; j < 4; ++j) { x[j] = lds[(kc + 8 * h + j) * 65 + n] * s; y[j] = lds[(kc + 8 * h + 4 + j) * 65 + n] * s; }
                *(bf16x8*)(pj.dst + (size_t)(pj.row0 + n) * pj.ldd + pj.k0 + kc + 8 * h) = pack8(x, y); }
            __syncthreads();
        }
    }
    float* sw = (float*)(ws + WS_SGUW);
    for (int i = blockIdx.x * 512 + tid; i < 8 * 128 * 128; i += gridDim.x * 512) { const int s = i & 127, t = (i >> 7) & 127; sw[i] = (s <= t) ? a.in[I_SGUW][i] : 0.f; }
}

__device__ void phase_h(int wv, const float* xin, const float* normg, const float* ada, bf16_t* H, bool with_glr, const float* oinw, float* GLR, LAS float* lds) {
    const int tid = opaque_tid(wv), lane = tid & 63, wave = tid >> 6;
    if (with_glr) { for (int i = tid; i < 16384; i += 512) { const int c = i >> 4, j = i & 15; lds[j * 1024 + c] = oinw[(size_t)c * 7184 + 2048 + j]; } __syncthreads(); }
    f32x4 gh[4];
#pragma unroll
    for (int i = 0; i < 4; ++i) gh[i] = *(const f32x4*)(normg + i * 256 + lane * 4);
    for (int r0 = (blockIdx.x * 8 + wave) * 2; r0 < M; r0 += gridDim.x * 16) {
        f32x4 xr[2][4], sc4[4], sh4[4];
        { const float* ab0 = ada + (size_t)(r0 >> 11) * 3072;
#pragma unroll
          for (int i = 0; i < 4; ++i) { sc4[i] = *(const f32x4*)(ab0 + 1024 + i * 256 + lane * 4); sh4[i] = *(const f32x4*)(ab0 + i * 256 + lane * 4); } }
#pragma unroll
        for (int u = 0; u < 2; ++u)
#pragma unroll
            for (int i = 0; i < 4; ++i) xr[u][i] = *(const f32x4*)(xin + (size_t)(r0 + u) * D + i * 256 + lane * 4);
        __builtin_amdgcn_sched_barrier(0);
#pragma unroll
        for (int u = 0; u < 2; ++u) {
        const int r = r0 + u;
        const int b = r >> 11; const float* ab = ada + (size_t)b * 3072;
        f32x4 x4[4]; float ssq = 0.f;
#pragma unroll
        for (int i = 0; i < 4; ++i) { x4[i] = xr[u][i]; ssq += x4[i][0] * x4[i][0] + x4[i][1] * x4[i][1] + x4[i][2] * x4[i][2] + x4[i][3] * x4[i][3]; }
        ssq = wave_sum(ssq);
        const float rstd = __builtin_amdgcn_rsqf(ssq * (1.0f / 1024.0f) + EPS);
#pragma unroll
        for (int i = 0; i < 4; ++i) { const int c = i * 256 + lane * 4;
            x4[i] = x4[i] * rstd * gh[i] * (sc4[i] + 1.0f) + sh4[i];
            u32x2 w; w.x = cvt_pk_bf16(x4[i][0], x4[i][1]); w.y = cvt_pk_bf16(x4[i][2], x4[i][3]);
            *(u32x2*)(H + (size_t)r * D + c) = w; }
        if (with_glr) {
            float v[16]; int lo = lane * 4; asm volatile("" : "+v"(lo));
#pragma unroll
            for (int qg = 0; qg < 8; ++qg) { f32x4 wq[2][4];
#pragma unroll
                for (int qq = 0; qq < 2; ++qq)
#pragma unroll
                    for (int i = 0; i < 4; ++i) wq[qq][i] = *(const LAS f32x4*)(lds + (2 * qg + qq) * 1024 + i * 256 + lo);
                __builtin_amdgcn_sched_barrier(0);
#pragma unroll
                for (int qq = 0; qq < 2; ++qq) { float s = 0.f;
#pragma unroll
                    for (int i = 0; i < 4; ++i) s += x4[i][0] * wq[qq][i][0] + x4[i][1] * wq[qq][i][1] + x4[i][2] * wq[qq][i][2] + x4[i][3] * wq[qq][i][3];
                    v[2 * qg + qq] = s; }
                __builtin_amdgcn_sched_barrier(0); }
#define GLR_STEP(NN, MASK) do { float rcv[NN]; const bool up = (lane & (MASK)) != 0; \
                _Pragma("unroll") for (int i = 0; i < (NN); ++i) { const float lo_ = v[i], hi_ = v[i + (NN)]; rcv[i] = __shfl_xor(up ? lo_ : hi_, (MASK)); } \
                _Pragma("unroll") for (int i = 0; i < (NN); ++i) { const float lo_ = v[i], hi_ = v[i + (NN)]; v[i] = (up ? hi_ : lo_) + rcv[i]; } } while (0)
            GLR_STEP(8, 32); GLR_STEP(4, 16); GLR_STEP(2, 8); GLR_STEP(1, 4);
#undef GLR_STEP
            v[0] += __shfl_xor(v[0], 2); v[0] += __shfl_xor(v[0], 1);
            if ((lane & 3) == 0) GLR[(size_t)r * 16 + (lane >> 2)] = v[0];
        }
        }
    }
    __syncthreads();
}

__device__ void phase_poolp(int wv, const bf16_t* AU, bf16_t* P) {
    const int tid = opaque_tid(wv);
#pragma unroll 1
    for (int j2 = tid; ; j2 += 512) { const int L = (int)blockIdx.x + (j2 >> 10) * (int)gridDim.x; if (L >= 512) break; const int job = j2 & 1023;
        const int c8 = (L & 3) * 32 + (job & 31), seg = (L >> 2) * 32 + (job >> 5), T0 = seg * 8, col = c8 * 8, g = col >> 8, w = 2 << g, tin = T0 & 2047;
        const bf16_t* base = AU + (size_t)T0 * 2048 + col;
        const u32x4 zero = {0u, 0u, 0u, 0u};
        u32x4 prev[15], curv[8], oldv[8];
#pragma unroll
        for (int i = 1; i < 16; ++i) { const bool ok = (i < w && tin - i >= 0); prev[i - 1] = *(const u32x4*)(base - (ptrdiff_t)(ok ? i : 0) * 2048); }
#pragma unroll
        for (int tt = 0; tt < 8; ++tt) curv[tt] = *(const u32x4*)(base + (size_t)tt * 2048);
        oldv[0] = zero;
#pragma unroll
        for (int tt = 1; tt < 8; ++tt) { const bool ok = (tin + tt - w >= 0); oldv[tt] = *(const u32x4*)(base + (ptrdiff_t)(ok ? tt - w : 0) * 2048); }
        __builtin_amdgcn_sched_barrier(0);
        float sum[8];
#pragma unroll
        for (int j = 0; j < 8; ++j) sum[j] = 0.f;
#pragma unroll
        for (int i = 0; i < 15; ++i) { const u32x4 v = prev[i]; const float mk = ((i + 1) < w && tin - (i + 1) >= 0) ? 1.0f : 0.0f;
            sum[0] += mk * bflo(v.x); sum[1] += mk * bfhi(v.x); sum[2] += mk * bflo(v.y); sum[3] += mk * bfhi(v.y); sum[4] += mk * bflo(v.z); sum[5] += mk * bfhi(v.z); sum[6] += mk * bflo(v.w); sum[7] += mk * bfhi(v.w); }
#pragma unroll
        for (int tt = 0; tt < 8; ++tt) { const int pos = tin + tt;
            const u32x4 v = curv[tt];
            const float cur[8] = {bflo(v.x), bfhi(v.x), bflo(v.y), bfhi(v.y), bflo(v.z), bfhi(v.z), bflo(v.w), bfhi(v.w)};
#pragma unroll
            for (int j = 0; j < 8; ++j) sum[j] += cur[j];
            { const u32x4 o = oldv[tt]; const float mk = (tt > 0 && tin + tt - w >= 0) ? 1.0f : 0.0f;
              sum[0] -= mk * bflo(o.x); sum[1] -= mk * bfhi(o.x); sum[2] -= mk * bflo(o.y); sum[3] -= mk * bfhi(o.y); sum[4] -= mk * bflo(o.z); sum[5] -= mk * bfhi(o.z); sum[6] -= mk * bflo(o.w); sum[7] -= mk * bfhi(o.w); }
            const float inv = 1.0f / (float)(pos + 1 < w ? pos + 1 : w);
            u32x4 o; o.x = cvt_pk_bf16(sum[0] * inv - cur[0], sum[1] * inv - cur[1]); o.y = cvt_pk_bf16(sum[2] * inv - cur[2], sum[3] * inv - cur[3]);
            o.z = cvt_pk_bf16(sum[4] * inv - cur[4], sum[5] * inv - cur[5]); o.w = cvt_pk_bf16(sum[6] * inv - cur[6], sum[7] * inv - cur[7]);
            *(u32x4*)(P + (size_t)(T0 + tt) * 1024 + col) = o; }
    }
}

__device__ void phase_sgu(int wv, const bf16_t* AU, const bf16_t* V0, bf16_t* Y0, const float* SGUW, const float* sgub, const float* sgug, LAS float* lds) {
    const int tid = opaque_tid(wv), lane = tid & 63, hh = tid >> 6, fr = lane & 15, fq = lane >> 4;
    for (int chunk = blockIdx.x; chunk < M / 128; chunk += gridDim.x) {
        const int tok0 = chunk * 128;
        {
          const int g = tid >> 7, kq = (tid >> 5) & 3, j = tid & 31;
          const bf16_t* vp = V0 + ((size_t)((tok0 >> 5) + g) * 1024 + j) * 32 + kq * 8;
          float ac[8];
#pragma unroll
          for (int e = 0; e < 8; ++e) ac[e] = 0.f;
          for (int ib = 0; ib < 4; ++ib) { u32x4 vv[8];
#pragma unroll
              for (int i = 0; i < 8; ++i) vv[i] = *(const u32x4*)(vp + (size_t)(8 * ib + i) * 32 * 32);
              __builtin_amdgcn_sched_barrier(0);
#pragma unroll
              for (int i = 0; i < 8; ++i) { const u32x4 v = vv[i];
                  const float f0 = bflo(v.x), f1 = bfhi(v.x), f2 = bflo(v.y), f3 = bfhi(v.y), f4 = bflo(v.z), f5 = bfhi(v.z), f6 = bflo(v.w), f7 = bfhi(v.w);
                  ac[0] += f0 * f0; ac[1] += f1 * f1; ac[2] += f2 * f2; ac[3] += f3 * f3; ac[4] += f4 * f4; ac[5] += f5 * f5; ac[6] += f6 * f6; ac[7] += f7 * f7; } }
#pragma unroll
          for (int e = 0; e < 8; ++e) {
#pragma unroll
              for (int m = 16; m >= 1; m >>= 1) ac[e] += __shfl_xor(ac[e], m); }
          if (j == 0) {
#pragma unroll
              for (int e = 0; e < 8; ++e) lds[32 * g + 16 * (e >> 2) + 4 * kq + (e & 3)] = __builtin_amdgcn_rsqf(ac[e] * (1.0f / 1024.0f) + EPS); } }
        __syncthreads();
        f32x4 gsg[8];
#pragma unroll
        for (int n = 0; n < 8; ++n) gsg[n] = *(const f32x4*)(sgug + hh * 128 + 16 * n + 4 * fq);
        for (int mp = 0; mp < 4; ++mp) {
            f32x4 acc[2][8];
#pragma unroll
            for (int i = 0; i < 2; ++i)
#pragma unroll
                for (int n = 0; n < 8; ++n) acc[i][n] = (f32x4){0.f, 0.f, 0.f, 0.f};
            for (int ks = 0; ks <= mp; ++ks) {
                const int s0 = 32 * ks + 4 * fq;
                bf16x8 bfv[8];
#pragma unroll
                for (int n = 0; n < 8; ++n) bfv[n] = *(const bf16x8*)(V0 + ((size_t)((tok0 >> 5) + ks) * 1024 + hh * 128 + 16 * n + fr) * 32 + fq * 8);
                const f32x4 ra = *(const LAS f32x4*)(lds + s0), rb = *(const LAS f32x4*)(lds + s0 + 16);
                f32x4 wl[2][2];
#pragma unroll
                for (int i = 0; i < 2; ++i) { const float* wrow = SGUW + ((size_t)hh * 128 + 16 * (2 * mp + i) + fr) * 128; wl[i][0] = *(const f32x4*)(wrow + s0); wl[i][1] = *(const f32x4*)(wrow + s0 + 16); }
                __builtin_amdgcn_sched_barrier(0);
                bf16x8 af[2];
#pragma unroll
                for (int i = 0; i < 2; ++i) af[i] = pack8(wl[i][0] * ra, wl[i][1] * rb);
#pragma unroll
                for (int n = 0; n < 8; ++n) { acc[0][n] = MFMA16(bfv[n], af[0], acc[0][n]); acc[1][n] = MFMA16(bfv[n], af[1], acc[1][n]); }
            }
#pragma unroll
            for (int i = 0; i < 2; ++i) { const int t = 16 * (2 * mp + i) + fr; const float bb = sgub[hh * 128 + t];
                u32x2 uu[8], GG[8];
#pragma unroll
                for (int n = 0; n < 8; ++n) { const int col = hh * 128 + 16 * n + 4 * fq;
                    uu[n] = *(const u32x2*)(AU + (size_t)(tok0 + t) * 2048 + 1024 + col); GG[n] = *(const u32x2*)(Y0 + (size_t)(tok0 + t) * 2048 + 1024 + col); }
                __builtin_amdgcn_sched_barrier(0);
#pragma unroll
                for (int n = 0; n < 8; ++n) { const int col = hh * 128 + 16 * n + 4 * fq;
                    const f32x4 g = gsg[n];
                    bf16_t* yp = Y0 + (size_t)(tok0 + t) * 2048 + 1024 + col;
                    const u32x2 u = uu[n], G = GG[n];
                    const f32x4 z = acc[i][n] * g + bb;
                    u32x2 o; o.x = cvt_pk_bf16(z[0] * bflo(u.x) * bflo(G.x), z[1] * bfhi(u.x) * bfhi(G.x)); o.y = cvt_pk_bf16(z[2] * bflo(u.y) * bflo(G.y), z[3] * bfhi(u.y) * bfhi(G.y));
                    *(u32x2*)yp = o; } }
        }
        __syncthreads();
    }
}

typedef short s16x4 __attribute__((ext_vector_type(4)));
constexpr int GP_GLR = 0, GP_TOT = 4096;
__device__ void phase_glapre(int wv, bf16_t* QK, const float* GLR, float* EB, const float* ggw, const float* ggb, LAS unsigned char* lds) {
    const int tid = opaque_tid(wv);
    LAS float* sGLR = (LAS float*)(lds + GP_GLR); LAS float* sTOT = (LAS float*)(lds + GP_TOT);
    const int k = tid & 127, sq = tid >> 7;
    f32x4 pg = (f32x4){0.f, 0.f, 0.f, 0.f}; unsigned short pq[16], pkk[16];
#define GP_LOAD(itt) do { const int _b = (itt) >> 7, _hh = ((itt) >> 5) & 3, _n = (itt) & 31, _t0 = _b * 2048 + _n * 64; \
        if (tid < 256) pg = *(const f32x4*)(GLR + (size_t)_t0 * 16 + tid * 4); \
        _Pragma("unroll") for (int i = 0; i < 16; ++i) { const size_t ro = (size_t)(_t0 + 16 * sq + i) * 4096 + _hh * 128 + k; pq[i] = QK[ro]; pkk[i] = QK[ro + 512]; } } while (0)
    if ((int)blockIdx.x < 2048) GP_LOAD((int)blockIdx.x);
    float gw[16], gb = 0.f; int hh_ld = -1;
#pragma unroll
    for (int j = 0; j < 16; ++j) gw[j] = 0.f;
    for (int it = blockIdx.x; it < 2048; it += gridDim.x) {
        const int b = it >> 7, hh = (it >> 5) & 3, n = it & 31, col = hh * 128 + k, tok0 = b * 2048 + n * 64;
        if (hh != hh_ld) { hh_ld = hh;
#pragma unroll
            for (int j = 0; j < 16; ++j) gw[j] = ggw[j * 512 + col];
            gb = ggb[col]; }
        if (tid < 256) *(LAS f32x4*)(sGLR + tid * 4) = pg;
        float qv[16], kv[16];
#pragma unroll
        for (int i = 0; i < 16; ++i) { qv[i] = bf2f(pq[i]); kv[i] = bf2f(pkk[i]); }
        __syncthreads();
        if (it + (int)gridDim.x < 2048) GP_LOAD(it + (int)gridDim.x);
        float c[16]; float run = 0.f;
#pragma unroll
        for (int i = 0; i < 16; ++i) { const int s = 16 * sq + i; float dot = gb;
#pragma unroll
            for (int j4 = 0; j4 < 4; ++j4) { const f32x4 gl = *(const LAS f32x4*)(sGLR + s * 16 + j4 * 4); dot += gl[0] * gw[j4 * 4] + gl[1] * gw[j4 * 4 + 1] + gl[2] * gw[j4 * 4 + 2] + gl[3] * gw[j4 * 4 + 3]; }
            run += logsig2_f(dot * 1.4426950408889634f) * (1.0f / 16.0f); c[i] = run; }
        sTOT[sq * 128 + k] = run;
        __syncthreads();
        const float t0 = sTOT[k], t1 = sTOT[128 + k], t2 = sTOT[256 + k], t3 = sTOT[384 + k];
        const float pre = (sq > 0 ? t0 : 0.f) + (sq > 1 ? t1 : 0.f) + (sq > 2 ? t2 : 0.f), blast = t0 + t1 + t2 + t3;
#pragma unroll
        for (int i = 0; i < 16; ++i) { const size_t ro = (size_t)(tok0 + 16 * sq + i) * 4096 + col; const float bc = pre + c[i];
            QK[ro] = f2bf(qv[i] * 0.08838834764831845f * __builtin_amdgcn_exp2f(bc));
            QK[ro + 512] = f2bf(kv[i] * __builtin_amdgcn_exp2f(-bc)); }
        if (sq == 0) EB[(size_t)it * 128 + k] = __builtin_amdgcn_exp2f(blast);
        __syncthreads();
    }
#undef GP_LOAD
}

constexpr int G2_BUF = 43520, G2_QD = 0, G2_KI = 17408, G2_VT = 34816, G2_EB = 43008, G2_ST = 2 * G2_BUF, G2_STB = 17408;
__device__ void phase_gla2(int wv, const bf16_t* QK, const bf16_t* V1, bf16_t* YC  , const float* EB, float* SSQ, LAS unsigned char* lds) {
    const int tid = opaque_tid(wv), lane = tid & 63, fr = lane & 15, fq = lane >> 4;
    for (int item = blockIdx.x; item < 256; item += gridDim.x) {
        const int b = item >> 4, hh = (item >> 2) & 3, vs = item & 3;
        f32x4 S[2][4];
#pragma unroll
        for (int kk = 0; kk < 2; ++kk)
#pragma unroll
            for (int i = 0; i < 4; ++i) S[kk][i] = (f32x4){0.f, 0.f, 0.f, 0.f};
        u32x4 pqd[2], pki[2], pvv; float peb = 0.f;
#define G2_LOAD(nn) do { const int _t0 = b * 2048 + (nn) * 64; \
            _Pragma("unroll") for (int i = 0; i < 2; ++i) { const int ch = tid + 512 * i, s = ch >> 4, c16 = ch & 15; const bf16_t* p = QK + (size_t)(_t0 + s) * 4096 + hh * 128 + c16 * 8; \
                pqd[i] = *(const u32x4*)p; pki[i] = *(const u32x4*)(p + 512); } \
            { const int grp = tid >> 8, v = (tid >> 2) & 63, ch = tid & 3; pvv = *(const u32x4*)(V1 + ((size_t)((_t0 >> 5) + grp) * 2048 + hh * 256 + vs * 64 + v) * 32 + ch * 8); } \
            if (tid < 128) peb = EB[((size_t)((b * 4 + hh) * 32 + (nn))) * 128 + tid]; } while (0)
#define G2_STORE(bb) do { LAS unsigned char* _q = lds + (bb) * G2_BUF; \
            _Pragma("unroll") for (int i = 0; i < 2; ++i) { const int ch = tid + 512 * i, s = ch >> 4, c16 = ch & 15; \
                *(LAS u32x4*)((LAS bf16_t*)(_q + G2_QD) + s * 136 + c16 * 8) = pqd[i]; *(LAS u32x4*)((LAS bf16_t*)(_q + G2_KI) + s * 136 + c16 * 8) = pki[i]; } \
            { const int grp = tid >> 8, v = (tid >> 2) & 63, ch = tid & 3; *(LAS u32x4*)((LAS bf16_t*)(_q + G2_VT) + (grp * 64 + v) * 32 + ch * 8) = pvv; } \
            if (tid < 128) ((LAS float*)(_q + G2_EB))[tid] = peb; } while (0)
        G2_LOAD(0);
        __syncthreads();
        for (int i = tid; i < G2_STB / 4; i += 512) ((LAS unsigned*)(lds + G2_ST))[i] = 0u;
        G2_STORE(0);
        G2_LOAD(1);
        __syncthreads();
        for (int n = 0; n < 32; ++n) {
            const int tok0 = b * 2048 + n * 64;
            LAS unsigned char* cb = lds + (n & 1) * G2_BUF;
            LAS bf16_t* sQD = (LAS bf16_t*)(cb + G2_QD); LAS bf16_t* sKI = (LAS bf16_t*)(cb + G2_KI); LAS bf16_t* sVT = (LAS bf16_t*)(cb + G2_VT); LAS float* sEB = (LAS float*)(cb + G2_EB);
            LAS bf16_t* stR = (LAS bf16_t*)(lds + G2_ST + (n & 1) * G2_STB);
            LAS bf16_t* stW = (LAS bf16_t*)(lds + G2_ST + ((n + 1) & 1) * G2_STB);
            if (wv < 4) {
              const int tt = wv;
              bf16x8 qf[4];
#pragma unroll
              for (int ks = 0; ks < 4; ++ks) qf[ks] = *(const LAS bf16x8*)(sQD + (16 * tt + fr) * 136 + 32 * ks + 8 * fq);
              f32x4 att[4];
#pragma unroll
              for (int st = 0; st < 4; ++st) att[st] = (f32x4){0.f, 0.f, 0.f, 0.f};
#pragma unroll
              for (int kh = 0; kh < 2; ++kh) {
                  bf16x8 kf[4][2];
#pragma unroll
                  for (int st = 0; st < 4; ++st)
#pragma unroll
                      for (int k2 = 0; k2 < 2; ++k2) kf[st][k2] = *(const LAS bf16x8*)(sKI + (16 * st + fr) * 136 + 32 * (2 * kh + k2) + 8 * fq);
                  __builtin_amdgcn_sched_barrier(0);
#pragma unroll
                  for (int k2 = 0; k2 < 2; ++k2)
#pragma unroll
                      for (int st = 0; st < 4; ++st) att[st] = MFMA16(kf[st][k2], qf[2 * kh + k2], att[st]);
                  __builtin_amdgcn_sched_barrier(0); }
#pragma unroll
              for (int st = 0; st < 4; ++st) {
#pragma unroll
                  for (int r = 0; r < 4; ++r) { const bool keep = (st < tt) || (st == tt && 4 * fq + r <= fr); att[st][r] = keep ? att[st][r] : 0.f; } }
              const bf16x8 wf0 = pack8(att[0], att[1]), wf1 = pack8(att[2], att[3]);
              float ss = 0.f;
#pragma unroll
              for (int vh2 = 0; vh2 < 2; ++vh2) {
                  bf16x8 va[2][2], sa[2][4];
#pragma unroll
                  for (int i = 0; i < 2; ++i) { const int vt = 2 * vh2 + i;
                      va[0][i] = *(const LAS bf16x8*)(sVT + (16 * vt + fr) * 32 + fq * 8); va[1][i] = *(const LAS bf16x8*)(sVT + (64 + 16 * vt + fr) * 32 + fq * 8);
#pragma unroll
                      for (int ks = 0; ks < 4; ++ks) sa[i][ks] = *(const LAS bf16x8*)(stR + (16 * vt + fr) * 136 + 32 * ks + 8 * fq); }
                  __builtin_amdgcn_sched_barrier(0);
                  f32x4 o[2];
#pragma unroll
                  for (int i = 0; i < 2; ++i) o[i] = (f32x4){0.f, 0.f, 0.f, 0.f};
#pragma unroll
                  for (int i = 0; i < 2; ++i) o[i] = MFMA16(va[0][i], wf0, o[i]);
#pragma unroll
                  for (int i = 0; i < 2; ++i) o[i] = MFMA16(va[1][i], wf1, o[i]);
#pragma unroll
                  for (int ks = 0; ks < 4; ++ks)
#pragma unroll
                      for (int i = 0; i < 2; ++i) o[i] = MFMA16(sa[i][ks], qf[ks], o[i]);
                  __builtin_amdgcn_sched_barrier(0);
#pragma unroll
                  for (int i = 0; i < 2; ++i) { const int vt = 2 * vh2 + i;
                      u32x2 ow; ow.x = cvt_pk_bf16(o[i][0], o[i][1]); ow.y = cvt_pk_bf16(o[i][2], o[i][3]);
                      *(u32x2*)(YC + (size_t)(tok0 + 16 * tt + fr) * 4096 + hh * 256 + vs * 64 + 16 * vt + 4 * fq) = ow;
                      ss += o[i][0] * o[i][0] + o[i][1] * o[i][1] + o[i][2] * o[i][2] + o[i][3] * o[i][3]; } }
              ss += __shfl_xor(ss, 16); ss += __shfl_xor(ss, 32);
              if (lane < 16) { float* sp = SSQ + ((size_t)(tok0 + 16 * tt + fr) * 4 + hh) * 8 + vs * 2; sp[0] = ss; sp[1] = 0.f; }
            } else {
              const int kb = wv - 4;
              bf16x8 vf[2][4];
#pragma unroll
              for (int g2 = 0; g2 < 2; ++g2)
#pragma unroll
                  for (int vt = 0; vt < 4; ++vt) vf[g2][vt] = *(const LAS bf16x8*)(sVT + (64 * g2 + 16 * vt + fr) * 32 + fq * 8);
#pragma unroll
              for (int kk = 0; kk < 2; ++kk) { const int kt = 2 * kb + kk;
                  const f32x4 eb = *(const LAS f32x4*)(sEB + 16 * kt + 4 * fq);
                  bf16x8 ka[2];
#pragma unroll
                  for (int g2 = 0; g2 < 2; ++g2) {
                      const s16x4 lo = __builtin_amdgcn_ds_read_tr16_b64_v4i16((LAS s16x4*)(sKI + (32 * g2 + 4 * fq + (fr >> 2)) * 136 + 16 * kt + 4 * (fr & 3)));
                      const s16x4 hi = __builtin_amdgcn_ds_read_tr16_b64_v4i16((LAS s16x4*)(sKI + (32 * g2 + 16 + 4 * fq + (fr >> 2)) * 136 + 16 * kt + 4 * (fr & 3)));
                      ka[g2] = (bf16x8){lo[0], lo[1], lo[2], lo[3], hi[0], hi[1], hi[2], hi[3]}; }
#pragma unroll
                  for (int vt = 0; vt < 4; ++vt) {
                      S[kk][vt] = MFMA16(ka[0], vf[0][vt], S[kk][vt]);
                      S[kk][vt] = MFMA16(ka[1], vf[1][vt], S[kk][vt]);
                      S[kk][vt] = S[kk][vt] * eb;
                      u32x2 ow; ow.x = cvt_pk_bf16(S[kk][vt][0], S[kk][vt][1]); ow.y = cvt_pk_bf16(S[kk][vt][2], S[kk][vt][3]);
                      *(LAS u32x2*)(stW + (16 * vt + fr) * 136 + 16 * kt + 4 * fq) = ow; } } }
            if (n < 31) { G2_STORE((n + 1) & 1); if (n < 30) G2_LOAD(n + 2); }
            __syncthreads();
        }
#undef G2_LOAD
#undef G2_STORE
    }
}

constexpr int SB_K = 0, SB_V = 17408, SB_BUF = 16896;
__device__ void phase_sb(int wv, bf16_t* QK, const bf16_t* V1, LAS unsigned char* lds) {
    const int tid = opaque_tid(wv), lane = tid & 63, w = tid >> 6, fr = lane & 15, fq = lane >> 4;
    LAS bf16_t* sK = (LAS bf16_t*)(lds + SB_K); LAS bf16_t* sV = (LAS bf16_t*)(lds + SB_V); LAS int* sDone = (LAS int*)(lds + 2 * SB_BUF * 2); int it = 0;
    const float scale = 0.08838834764831845f * 1.4426950408889634f;
    for (int cc = blockIdx.x; cc < 256; cc += gridDim.x) {
        const int ph = cc >> 1, half = cc & 1, b = ph >> 3, hh = ph & 7;
        bf16x8 nq[4]; u32x4 nk[2], nv[2];
#define SB_QB(jj) (half ? (((jj) & 1) ? 4 + ((jj) >> 1) : 11 - ((jj) >> 1)) : (((jj) & 1) ? ((jj) >> 1) : 15 - ((jj) >> 1)))
#define SB_NEXT(jj) do { const int _qb = SB_QB(jj), _kb = 2 * _qb + 1; const size_t _qr = (size_t)(b * 2048 + 128 * _qb + 16 * w + fr) * 4096 + 1024 + hh * 128; \
            _Pragma("unroll") for (int ks = 0; ks < 4; ++ks) nq[ks] = *(const bf16x8*)(QK + _qr + 32 * ks + 8 * fq); \
            _Pragma("unroll") for (int i = 0; i < 2; ++i) { const int ch = tid + 512 * i; \
                { const int s = ch >> 4, c16 = ch & 15; nk[i] = *(const u32x4*)(QK + (size_t)(b * 2048 + 64 * _kb + s) * 4096 + 2048 + hh * 128 + c16 * 8); } \
                { const int grp = ch >> 9, d = (ch >> 2) & 127, c4 = ch & 3; nv[i] = *(const u32x4*)(V1 + ((size_t)(((b * 2048 + 64 * _kb) >> 5) + grp) * 2048 + 1024 + hh * 128 + d) * 32 + c4 * 8); } } } while (0)
        SB_NEXT(0);
        for (int j = 0; j < 8; ++j) {
            const int qb = SB_QB(j);
            const int tq = 128 * qb + 16 * w + fr;
            const size_t qrow = (size_t)(b * 2048 + tq) * 4096 + 1024 + hh * 128;
            bf16x8 qf[4];
#pragma unroll
            for (int ks = 0; ks < 4; ++ks) qf[ks] = nq[ks];
            u32x4 pk[2], pv[2];
            pk[0] = nk[0]; pk[1] = nk[1]; pv[0] = nv[0]; pv[1] = nv[1];
            if (j < 7) SB_NEXT(j + 1);
            f32x4 oacc[8];
#pragma unroll
            for (int d = 0; d < 8; ++d) oacc[d] = (f32x4){0.f, 0.f, 0.f, 0.f};
            float R = 0.f;
#define SB_LOAD(kbb) do { _Pragma("unroll") for (int i = 0; i < 2; ++i) { const int ch = tid + 512 * i; \
                { const int s = ch >> 4, c16 = ch & 15; pk[i] = *(const u32x4*)(QK + (size_t)(b * 2048 + 64 * (kbb) + s) * 4096 + 2048 + hh * 128 + c16 * 8); } \
                { const int grp = ch >> 9, d = (ch >> 2) & 127, c4 = ch & 3; pv[i] = *(const u32x4*)(V1 + ((size_t)(((b * 2048 + 64 * (kbb)) >> 5) + grp) * 2048 + 1024 + hh * 128 + d) * 32 + c4 * 8); } } } while (0)
#define SB_STORE(bufo) do { _Pragma("unroll") for (int i = 0; i < 2; ++i) { const int ch = tid + 512 * i; \
                { const int s = ch >> 4, c16 = ch & 15; *(LAS u32x4*)(sK + (bufo) + s * 136 + c16 * 8) = pk[i]; } \
                { const int grp = ch >> 9, d = (ch >> 2) & 127, c4 = ch & 3; *(LAS u32x4*)(sV + (bufo) + (grp * 128 + d) * 32 + c4 * 8) = pv[i]; } } } while (0)
            __syncthreads();
            SB_STORE(0);
            SB_LOAD(2 * qb);
            int cur = 0;
            for (int kb = 2 * qb + 1; kb >= 0; --kb) {
                const bool wdone = (__ballot(R >= -160.0f) == 0ull);
                if (lane == 0) sDone[(it & 1) * 8 + w] = wdone ? 0 : 1;
                __syncthreads();
                { const LAS int* dn = sDone + (it & 1) * 8; const int any = dn[0] | dn[1] | dn[2] | dn[3] | dn[4] | dn[5] | dn[6] | dn[7]; ++it; if (!any) break; }
                const int bo = cur * SB_BUF;
                if (kb > 0) { SB_STORE((cur ^ 1) * SB_BUF); if (kb > 1) SB_LOAD(kb - 2); }
                cur ^= 1;
                if (wdone || 64 * kb >= 128 * qb + 16 * w + 15) continue;
                f32x4 zt[4];
#pragma unroll
                for (int st = 0; st < 4; ++st) zt[st] = (f32x4){0.f, 0.f, 0.f, 0.f};
#pragma unroll
                for (int kh = 0; kh < 2; ++kh) {
                    bf16x8 kf[4][2];
#pragma unroll
                    for (int st = 0; st < 4; ++st)
#pragma unroll
                        for (int k2 = 0; k2 < 2; ++k2) kf[st][k2] = *(const LAS bf16x8*)(sK + bo + (16 * st + fr) * 136 + 32 * (2 * kh + k2) + 8 * fq);
                    __builtin_amdgcn_sched_barrier(0);
#pragma unroll
                    for (int k2 = 0; k2 < 2; ++k2)
#pragma unroll
                        for (int st = 0; st < 4; ++st) zt[st] = MFMA16(kf[st][k2], qf[2 * kh + k2], zt[st]);
                    __builtin_amdgcn_sched_barrier(0); }
                float lb[4][4], l1[4][4], P[4], sfx[4], TT[4];
#pragma unroll
                for (int st = 0; st < 4; ++st) { P[st] = 0.f;
#pragma unroll
                    for (int r = 0; r < 4; ++r) { const float zz = zt[st][r] * scale; const float lbv = logsig2_f(zz);
                        const bool strict = (64 * kb + 16 * st + 4 * fq + r) < tq;
                        lb[st][r] = strict ? lbv : -1.0e30f; l1[st][r] = strict ? (lbv - zz) : 0.f; P[st] += l1[st][r]; } }
#pragma unroll
                for (int st = 0; st < 4; ++st) { const float x16 = __shfl_xor(P[st], 16), x32 = __shfl_xor(P[st], 32), x48 = __shfl_xor(x16, 32);
                    TT[st] = P[st] + x16 + x32 + x48;
                    sfx[st] = fq == 0 ? (x16 + x32 + x48) : fq == 1 ? (x32 + x48) : fq == 2 ? x16 : 0.f; }
                float run = R;
#pragma unroll
                for (int st = 3; st >= 0; --st) { float a = run + sfx[st];
#pragma unroll
                    for (int r = 3; r >= 0; --r) { zt[st][r] = __builtin_amdgcn_exp2f(lb[st][r] + a); a += l1[st][r]; }
                    run += TT[st]; }
                R = run;
                const bf16x8 wf0 = pack8(zt[0], zt[1]), wf1 = pack8(zt[2], zt[3]);
#pragma unroll
                for (int dh = 0; dh < 2; ++dh) {
                    bf16x8 vf0[4], vf1[4];
#pragma unroll
                    for (int d4 = 0; d4 < 4; ++d4) { vf0[d4] = *(const LAS bf16x8*)(sV + bo + (16 * (4 * dh + d4) + fr) * 32 + fq * 8); vf1[d4] = *(const LAS bf16x8*)(sV + bo + (128 + 16 * (4 * dh + d4) + fr) * 32 + fq * 8); }
                    __builtin_amdgcn_sched_barrier(0);
#pragma unroll
                    for (int d4 = 0; d4 < 4; ++d4) oacc[4 * dh + d4] = MFMA16(vf0[d4], wf0, oacc[4 * dh + d4]);
#pragma unroll
                    for (int d4 = 0; d4 < 4; ++d4) oacc[4 * dh + d4] = MFMA16(vf1[d4], wf1, oacc[4 * dh + d4]);
                    __builtin_amdgcn_sched_barrier(0); }
            }
#pragma unroll
            for (int d = 0; d < 8; ++d) { u32x2 ow; ow.x = cvt_pk_bf16(oacc[d][0], oacc[d][1]); ow.y = cvt_pk_bf16(oacc[d][2], oacc[d][3]);
                *(u32x2*)(QK + qrow + 16 * d + 4 * fq) = ow; }
        }
    }
#undef SB_LOAD
#undef SB_STORE
#undef SB_NEXT
#undef SB_QB
    __syncthreads();
}

__device__ void phase_final(int wv, float* out, const float* g) {
    const int tid = opaque_tid(wv), lane = tid & 63, wave = tid >> 6;
    f32x4 gf[4];
#pragma unroll
    for (int i = 0; i < 4; ++i) gf[i] = *(const f32x4*)(g + i * 256 + lane * 4);
    for (int r0 = (blockIdx.x * 8 + wave) * 4; r0 < M; r0 += gridDim.x * 32) {
        f32x4 xr[4][4];
#pragma unroll
        for (int u = 0; u < 4; ++u)
#pragma unroll
            for (int i = 0; i < 4; ++i) xr[u][i] = *(const f32x4*)(out + (size_t)(r0 + u) * D + i * 256 + lane * 4);
        __builtin_amdgcn_sched_barrier(0);
#pragma unroll
        for (int u = 0; u < 4; ++u) { float ssq = 0.f;
#pragma unroll
            for (int i = 0; i < 4; ++i) ssq += xr[u][i][0] * xr[u][i][0] + xr[u][i][1] * xr[u][i][1] + xr[u][i][2] * xr[u][i][2] + xr[u][i][3] * xr[u][i][3];
            ssq = wave_sum(ssq);
            const float rstd = __builtin_amdgcn_rsqf(ssq * (1.0f / 1024.0f) + EPS);
#pragma unroll
            for (int i = 0; i < 4; ++i) *(f32x4*)(out + (size_t)(r0 + u) * D + i * 256 + lane * 4) = xr[u][i] * rstd * gf[i]; }
    }
}

#define XB_TMO      128
#define XB_XCNT(j)  (256  + 64 * (j))
#define XB_XSUB(j)  (1280 + 64 * (j))
#define XB_XGEN(j)  (2304 + 64 * (j))
#define XB_TOP      3328
#define XB_TOPGEN   3392
#define XCD_BAR_WORDS 3456
#define XB_SPIN_CAP (1u << 18)
__device__ __forceinline__ unsigned xb_ld(unsigned* p)              { return __hip_atomic_load(p, __ATOMIC_RELAXED, __HIP_MEMORY_SCOPE_AGENT); }
__device__ __forceinline__ unsigned xb_add(unsigned* p, unsigned v) { return __hip_atomic_fetch_add(p, v, __ATOMIC_RELAXED, __HIP_MEMORY_SCOPE_AGENT); }
__device__ __forceinline__ unsigned xb_xcc_id() { return (unsigned)__builtin_amdgcn_s_getreg((3 << 11) | 20) & 0xFu; }
#define XB_SPIN(cond, bar) do { unsigned _sp = 0; while (cond) { __builtin_amdgcn_s_sleep(1); \
    if ((++_sp & 255u) == 0u) { if (xb_ld(&(bar)[XB_TMO])) break; if (_sp > XB_SPIN_CAP) { atomicAdd(&(bar)[XB_TMO], 1u); break; } } } } while (0)
struct XcdBarrier { unsigned* bar; unsigned x; volatile LAS unsigned* st; };
__device__ __forceinline__ void xcd_barrier_complete(unsigned* bar, unsigned x, unsigned& nloc, unsigned& nx) {
    const unsigned G = gridDim.x * gridDim.y * gridDim.z;
    unsigned sum, cnt, mine, sp = 0u;
    for (;;) {
        sum = 0u; cnt = 0u; mine = 0u;
#pragma unroll
        for (unsigned j = 0; j < 16; ++j) { const unsigned c = xb_ld(&bar[XB_XCNT(j)]); sum += c; cnt += (c > 0u) ? 1u : 0u; mine = (j == x) ? c : mine; }
        if (sum == G) break;
        __builtin_amdgcn_s_sleep(1);
        if ((++sp & 255u) == 0u) { if (xb_ld(&bar[XB_TMO])) break; if (sp > XB_SPIN_CAP) { atomicAdd(&bar[XB_TMO], 1u); break; } }
    }
    nloc = mine > 0u ? mine : 1u; nx = cnt > 0u ? cnt : 1u;
}
__device__ __forceinline__ void xcd_barrier(const XcdBarrier& b, bool leader_thread) {
    asm volatile("s_waitcnt vmcnt(0)" ::: "memory");
    __syncthreads();
    if (leader_thread) {
        unsigned* bar = b.bar;
        __builtin_amdgcn_s_waitcnt(0);
        unsigned nloc = b.st[0], nx = b.st[1];
        if (nloc == 0u) { xcd_barrier_complete(bar, b.x, nloc, nx); b.st[0] = nloc; b.st[1] = nx; }
        const unsigned old = xb_add(&bar[XB_XSUB(b.x)], 1u);
        const unsigned gen = old / nloc;
        if (old + 1u == (gen + 1u) * nloc) {
            __builtin_amdgcn_fence(__ATOMIC_RELEASE, "agent");
            asm volatile("s_waitcnt vmcnt(0)" ::: "memory");
            const unsigned og = xb_add(&bar[XB_TOP], 1u);
            const unsigned tg = og / nx;
            if (og + 1u == (tg + 1u) * nx) xb_add(&bar[XB_TOPGEN], 1u);
            else XB_SPIN(xb_ld(&bar[XB_TOPGEN]) == tg, bar);
            __builtin_amdgcn_fence(__ATOMIC_ACQUIRE, "agent");
            xb_add(&bar[XB_XGEN(b.x)], 1u);
            asm volatile("s_waitcnt vmcnt(0)" ::: "memory");
        } else {
            XB_SPIN(xb_ld(&bar[XB_XGEN(b.x)]) == gen, bar);
            __builtin_amdgcn_fence(__ATOMIC_ACQUIRE, "agent");
            asm volatile("s_waitcnt vmcnt(0)" ::: "memory");
        }
    }
    __syncthreads();
}

__global__ void __launch_bounds__(512, 2) mega_fwd(Args a) {
    extern __shared__ __attribute__((aligned(16))) unsigned char shm[];
    cg::grid_group grid = cg::this_grid();
    LAS unsigned char* lds = (LAS unsigned char*)shm;
    unsigned char* ws = a.ws;
    bf16_t* IN0T = (bf16_t*)(ws + WS_IN0T); bf16_t* OUT0T = (bf16_t*)(ws + WS_OUT0T); bf16_t* IN1T = (bf16_t*)(ws + WS_IN1T); bf16_t* OUT1T = (bf16_t*)(ws + WS_OUT1T);
    bf16_t* POOLT = (bf16_t*)(ws + WS_POOLT); float* SGUW = (float*)(ws + WS_SGUW); float* ADA = (float*)(ws + WS_ADA); float* GLR = (float*)(ws + WS_GLR); float* SSQ = (float*)(ws + WS_SSQ);
    bf16_t* H = (bf16_t*)(ws + WS_H); bf16_t* AU = (bf16_t*)(ws + WS_BUFA); bf16_t* Y0 = AU + (size_t)M * 2048; bf16_t* QK = AU;
    bf16_t* V0 = (bf16_t*)(ws + WS_BUFV); bf16_t* P = V0 + (size_t)M * 1024; bf16_t* V1 = V0;
    const int G = gridDim.x, c = blockIdx.x;
    const int wv = __builtin_amdgcn_readfirstlane(threadIdx.x >> 6);
    volatile LAS unsigned* xbst = (volatile LAS unsigned*)(lds + 131072);
    if (threadIdx.x == 0) { xbst[0] = 0u; xbst[1] = 0u; }
    __syncthreads();
    XcdBarrier xbar; xbar.bar = (unsigned*)(ws + WS_BAR); xbar.x = xb_xcc_id(); xbar.st = xbst;
    if (a.ph_hi - a.ph_lo > 1 && threadIdx.x == 0) (void)xb_add(&xbar.bar[XB_XCNT(xbar.x)], 1u);
    if (a.ph_lo < 0) grid.sync();
    for (int ph = a.ph_lo; ph < a.ph_hi; ++ph) {
        switch (ph) {
        case 0: phase_prep(wv, a, (LAS float*)lds); break;
        case 1: phase_h(wv, a.in[I_X], a.in[I_NORMG], ADA, H, false, nullptr, nullptr, (LAS float*)lds); break;
        case 2: {
            { pg8::Gemm g{H, H, IN0T}; pg8::StaticOrder S; S.init(M, 2048, G, c); pg8::EpiRow<0> E{AU, 2048, nullptr, nullptr};
              pg8::gemm_phase<pg8::EpiRow<0>, pg8::StaticOrder, true, 1024, 1024, 16>(wv, lds, g, S, E); }
            { pg8::Gemm g{H, H, IN0T + (size_t)2048 * 1024}; pg8::StaticOrder S; S.init(M, 1024, G, c); pg8::EpiVBlk E{V0, 1024};
              pg8::gemm_phase<pg8::EpiVBlk, pg8::StaticOrder, false, 1024, 1024, 16>(wv, lds, g, S, E); }
            { pg8::Gemm g{H, H, IN0T + (size_t)3072 * 1024}; pg8::StaticOrder S; S.init(M, 2048, G, c); pg8::EpiRow<1> E{Y0, 2048, nullptr, nullptr};
              pg8::gemm_phase<pg8::EpiRow<1>, pg8::StaticOrder, true, 1024, 1024, 16>(wv, lds, g, S, E); }
        } break;
        case 3: phase_poolp(wv, AU, P); phase_sgu(wv, AU, V0, Y0, SGUW, a.in[I_SGUB], a.in[I_SGUG], (LAS float*)lds); break;
        case 4: { asm volatile("s_waitcnt vmcnt(0)" ::: "memory"); __syncthreads();
              pg8::Gemm g{P, P, POOLT}; pg8::PoolOrder S{G, c}; pg8::EpiRow<2> E{Y0, 2048, nullptr, nullptr};
              pg8::gemm_phase<pg8::EpiRow<2>, pg8::PoolOrder, true, 256, 1024, 4>(wv, lds, g, S, E); } break;
        case 5: { pg8::Gemm g{Y0, Y0, OUT0T}; pg8::StaticOrder S; S.init(M, 1024, G, c); pg8::EpiOut E{a.in[I_X], a.out, ADA + 2048};
              pg8::gemm_phase<pg8::EpiOut, pg8::StaticOrder, true, 2048, 2048, 32>(wv, lds, g, S, E); } break;
        case 6: phase_h(wv, a.out, a.in[I_NORMG] + 1024, ADA + 16 * 3072, H, true, a.in[I_OINW], GLR, (LAS float*)lds); break;
        case 7: {
            { pg8::Gemm g{H, H, IN1T}; pg8::StaticOrder S; S.init(M, 3072, G, c); pg8::EpiRow<0> E{QK, 4096, nullptr, nullptr};
              pg8::gemm_phase<pg8::EpiRow<0>, pg8::StaticOrder, true, 1024, 1024, 16>(wv, lds, g, S, E); }
            { pg8::Gemm g{H, H, IN1T + (size_t)3072 * 1024}; pg8::StaticOrder S; S.init(M, 2048, G, c); pg8::EpiVBlk E{V1, 2048};
              pg8::gemm_phase<pg8::EpiVBlk, pg8::StaticOrder, false, 1024, 1024, 16>(wv, lds, g, S, E); }
        } break;
        case 8: phase_glapre(wv, QK, GLR, (float*)(ws + WS_EB), a.in[I_GGW], a.in[I_GGB], lds); phase_sb(wv, QK, V1, lds); break;
        case 9: phase_gla2(wv, QK, V1, QK + 3072, (const float*)(ws + WS_EB), SSQ, lds); break;
        case 10: { pg8::Gemm g{H, H, IN1T + (size_t)5120 * 1024}; pg8::StaticOrder S; S.init(M, 2048, G, c); pg8::EpiRow<3> E{QK, 4096, SSQ, a.in[I_GNG]};
              pg8::gemm_phase<pg8::EpiRow<3>, pg8::StaticOrder, true, 1024, 1024, 16>(wv, lds, g, S, E); } break;
        case 11: { pg8::Gemm g{QK + 3072, QK + 1024, OUT1T}; pg8::StaticOrder S; S.init(M, 1024, G, c); pg8::EpiOut E{a.out, a.out, ADA + 16 * 3072 + 2048};
              pg8::gemm_phase<pg8::EpiOut, pg8::StaticOrder, true, 2048, 4096, 16>(wv, lds, g, S, E); } break;
        case 12: phase_final(wv, a.out, a.in[I_FG]); break;
        }
        if (ph + 1 < a.ph_hi && ph != 3) xcd_barrier(xbar, opaque_tid(wv) == 0);
    }
}

extern "C" void kernel_launch(void* const* d_in, const int* in_sizes, int n_in, void* d_out, int out_size, void* d_ws, size_t ws_size, hipStream_t stream) {
    static int grid = 0;
    if (grid == 0) {
        if (n_in != 18 || out_size != M * D || ws_size < WS_END) { fprintf(stderr, "kernel_launch: unexpected shapes (n_in %d out %d ws %zu need %zu)\n", n_in, out_size, ws_size, (size_t)WS_END); grid = -1; return; }
        int dev = 0, cus = 0, per_cu = 0;
        hipGetDevice(&dev); hipDeviceGetAttribute(&cus, hipDeviceAttributeMultiprocessorCount, dev);
        if (hipFuncSetAttribute((const void*)mega_fwd, hipFuncAttributeMaxDynamicSharedMemorySize, LDS_BYTES) != hipSuccess) { fprintf(stderr, "kernel_launch: hipFuncSetAttribute failed\n"); grid = -1; return; }
        if (hipOccupancyMaxActiveBlocksPerMultiprocessor(&per_cu, (const void*)mega_fwd, 512, LDS_BYTES) != hipSuccess || per_cu < 1) { fprintf(stderr, "kernel_launch: occupancy query says %d blocks/CU\n", per_cu); per_cu = 1; }
        (void)hipGetLastError();
        grid = cus;
    }
    if (grid < 0) return;
    Args a{};
    for (int i = 0; i < 18; ++i) a.in[i] = (const float*)d_in[i];
    a.out = (float*)d_out; a.ws = (unsigned char*)d_ws;
#if N_LAUNCH_MODE == 1
    a.ph_lo = 0; a.ph_hi = NPHASE;
    (void)hipMemsetAsync((unsigned char*)d_ws + WS_BAR, 0, 16384, stream);
    void* args[] = {&a};
    hipError_t e = hipLaunchCooperativeKernel((const void*)mega_fwd, dim3(grid), dim3(512), args, LDS_BYTES, stream);
    if (e != hipSuccess) fprintf(stderr, "cooperative launch failed: %s (grid %d)\n", hipGetErrorString(e), grid);
#else
    for (int ph = 0; ph < NPHASE; ++ph) { a.ph_lo = ph; a.ph_hi = ph + 1; hipLaunchKernelGGL(mega_fwd, dim3(grid), dim3(512), LDS_BYTES, stream, a); }
#endif
}
```
